# Optimizing an MI355X kernel written in HIP

```python
import math
import jax, jax.numpy as jnp
from jax import lax
import numpy as np

D_MODEL = 2048
BATCH = 1
SEQ = 8192
DEPTH = 4

HEAD_DIM = 128
GRID_W = 64
NA_HEADS = 8
NA_WIDTH = NA_HEADS * HEAD_DIM
NA_WIN_R = 8
NA_WIN_C = 16
WA_HEADS = 8
WA_KV_HEADS = 2
WA_WIDTH = WA_HEADS * HEAD_DIM
WA_KV_WIDTH = WA_KV_HEADS * HEAD_DIM
WA_WINDOW = 128
WA_BLOCK = 128
MIX_WIDTH = NA_WIDTH + WA_WIDTH
PROJ_SPLITS = (NA_WIDTH, NA_WIDTH, NA_WIDTH, WA_WIDTH, WA_KV_WIDTH, WA_KV_WIDTH)
PROJ_WIDTH = sum(PROJ_SPLITS)
D_FF = 5632
CONV_W = 3
ROPE_THETA = 10000.0
EPS = 1e-6
NEG = -1e30

kernel_name = "hybrid_na_swa_convffn_encoder"


def rms_norm(x, g):
    xf = x.astype(jnp.float32)
    y = xf * lax.rsqrt(jnp.mean(xf * xf, axis=-1, keepdims=True) + EPS)
    return (y * g.astype(jnp.float32)).astype(x.dtype)


def rope(x, positions):
    d = x.shape[-1]
    inv = ROPE_THETA ** (-jnp.arange(0, d, 2, dtype=jnp.float32) / d)
    ang = positions.astype(jnp.float32)[:, None] * inv[None, :]
    cos = jnp.cos(ang)[None, :, None, :]
    sin = jnp.sin(ang)[None, :, None, :]
    xf = x.astype(jnp.float32)
    x1, x2 = xf[..., : d // 2], xf[..., d // 2:]
    out = jnp.concatenate([x1 * cos - x2 * sin, x2 * cos + x1 * sin], axis=-1)
    return out.astype(x.dtype)


def neighborhood_attention(q, k, v, rpb):
    b, s, h, d = q.shape
    rows = s // GRID_W
    wr = min(NA_WIN_R, rows)
    wc = NA_WIN_C
    qg = q.reshape(b, rows, GRID_W, h, d)
    kg = k.reshape(b, rows, GRID_W, h, d)
    vg = v.reshape(b, rows, GRID_W, h, d)
    r = jnp.arange(rows)
    row_start = jnp.clip(r - wr // 2, 0, rows - wr)
    row_idx = row_start[:, None] + jnp.arange(wr)[None, :]
    k_rows = kg[:, row_idx]
    v_rows = vg[:, row_idx]
    c = jnp.arange(GRID_W)
    col_start = jnp.clip(c - wc // 2, 0, GRID_W - wc)
    col_mask = (c[None, :] >= col_start[:, None]) & (c[None, :] < col_start[:, None] + wc)
    dr = row_idx - r[:, None] + (NA_WIN_R - 1)
    dc = jnp.clip(c[None, :] - c[:, None], -(wc - 1), wc - 1) + (NA_WIN_C - 1)
    bias = rpb[:, dr]
    bias = bias[:, :, :, dc]
    bias = jnp.transpose(bias, (0, 1, 3, 2, 4)).astype(jnp.float32)
    scale = 1.0 / math.sqrt(d)
    sc = jnp.einsum('brqhd,brwkhd->bhrqwk', qg, k_rows).astype(jnp.float32) * scale
    sc = sc + bias[None]
    sc = jnp.where(col_mask[:, None, :], sc, NEG)
    shp = sc.shape
    p = jax.nn.softmax(sc.reshape(shp[:-2] + (wr * GRID_W,)), axis=-1).reshape(shp)
    out = jnp.einsum('bhrqwk,brwkhd->brqhd', p.astype(v.dtype), v_rows)
    return out.reshape(b, s, h * d)


def windowed_gqa_sink(q, k, v, sink):
    b, s, hq, d = q.shape
    hkv = k.shape[2]
    g = hq // hkv
    nb = s // WA_BLOCK
    qb = q.reshape(b, nb, WA_BLOCK, hkv, g, d)
    pad = ((0, 0), (WA_BLOCK, WA_BLOCK), (0, 0), (0, 0))
    kp = jnp.pad(k, pad).reshape(b, nb + 2, WA_BLOCK, hkv, d)
    vp = jnp.pad(v, pad).reshape(b, nb + 2, WA_BLOCK, hkv, d)
    kw = jnp.concatenate([kp[:, :-2], kp[:, 1:-1], kp[:, 2:]], axis=2)
    vw = jnp.concatenate([vp[:, :-2], vp[:, 1:-1], vp[:, 2:]], axis=2)
    blk = jnp.arange(nb)[:, None]
    qpos = blk * WA_BLOCK + jnp.arange(WA_BLOCK)[None, :]
    kpos = (blk - 1) * WA_BLOCK + jnp.arange(3 * WA_BLOCK)[None, :]
    diff = kpos[:, None, :] - qpos[:, :, None]
    valid = (jnp.abs(diff) <= WA_WINDOW) & (kpos[:, None, :] >= 0) & (kpos[:, None, :] < s)
    scale = 1.0 / math.sqrt(d)
    sc = jnp.einsum('bnqhgd,bnkhd->bhgnqk', qb, kw).astype(jnp.float32) * scale
    sc = jnp.where(valid, sc, NEG)
    sink_l = sink.astype(jnp.float32).reshape(hkv, g)[None, :, :, None, None, None]
    m = jnp.maximum(jnp.max(sc, axis=-1, keepdims=True), sink_l)
    e = jnp.exp(sc - m)
    p = e / (jnp.sum(e, axis=-1, keepdims=True) + jnp.exp(sink_l - m))
    out = jnp.einsum('bhgnqk,bnkhd->bnqhgd', p.astype(v.dtype), vw)
    return out.reshape(b, s, hq * d)


def depthwise_conv(u, w, bias):
    up = jnp.pad(u, ((0, 0), (1, 1), (0, 0)))
    return up[:, :-2] * w[0] + up[:, 1:-1] * w[1] + up[:, 2:] * w[2] + bias


def setup_inputs(seed: int = 0) -> dict:
    key = jax.random.key(seed)
    ks = jax.random.split(key, 20)
    f32 = jnp.float32
    nrm = lambda k, shp, sc: jax.random.normal(k, shp, f32) * sc
    centre = jnp.zeros((CONV_W, 1), f32).at[CONV_W // 2].set(1.0)
    return {
        "x": nrm(ks[0], (BATCH, SEQ, D_MODEL), 1.0),
        "positions": jnp.arange(SEQ, dtype=jnp.int32),
        "ln1_g": 1.0 + nrm(ks[1], (DEPTH, D_MODEL), 0.02),
        "w_in": nrm(ks[2], (DEPTH, D_MODEL, PROJ_WIDTH), D_MODEL ** -0.5),
        "qn_a": 1.0 + nrm(ks[3], (DEPTH, HEAD_DIM), 0.02),
        "kn_a": 1.0 + nrm(ks[4], (DEPTH, HEAD_DIM), 0.02),
        "rpb": nrm(ks[5], (DEPTH, NA_HEADS, 2 * NA_WIN_R - 1, 2 * NA_WIN_C - 1), 0.1),
        "qn_b": 1.0 + nrm(ks[6], (DEPTH, HEAD_DIM), 0.02),
        "kn_b": 1.0 + nrm(ks[7], (DEPTH, HEAD_DIM), 0.02),
        "sink": nrm(ks[8], (DEPTH, WA_HEADS), 0.5),
        "on_a": 1.0 + nrm(ks[9], (DEPTH, NA_WIDTH), 0.02),
        "on_b": 1.0 + nrm(ks[10], (DEPTH, WA_WIDTH), 0.02),
        "w_out": nrm(ks[11], (DEPTH, MIX_WIDTH, D_MODEL), 0.5 * MIX_WIDTH ** -0.5),
        "ln2_g": 1.0 + nrm(ks[12], (DEPTH, D_MODEL), 0.02),
        "w_up": nrm(ks[13], (DEPTH, D_MODEL, 2 * D_FF), D_MODEL ** -0.5),
        "conv_w": centre[None] + nrm(ks[14], (DEPTH, CONV_W, 2 * D_FF), 0.3),
        "conv_b": nrm(ks[15], (DEPTH, 2 * D_FF), 0.01),
        "w_down": nrm(ks[16], (DEPTH, D_FF, D_MODEL), 0.5 * D_FF ** -0.5),
    }


def reference(x, positions, ln1_g, w_in, qn_a, kn_a, rpb, qn_b, kn_b, sink,
              on_a, on_b, w_out, ln2_g, w_up, conv_w, conv_b, w_down):
    b, s, _ = x.shape
    cuts = list(np.cumsum(PROJ_SPLITS)[:-1])
    for l in range(DEPTH):
        h = rms_norm(x, ln1_g[l])
        proj = h @ w_in[l]
        qa, ka, va, qb, kb, vb = jnp.split(proj, cuts, axis=-1)
        qa = rms_norm(qa.reshape(b, s, NA_HEADS, HEAD_DIM), qn_a[l])
        ka = rms_norm(ka.reshape(b, s, NA_HEADS, HEAD_DIM), kn_a[l])
        va = va.reshape(b, s, NA_HEADS, HEAD_DIM)
        oa = neighborhood_attention(qa, ka, va, rpb[l])
        qb = rope(rms_norm(qb.reshape(b, s, WA_HEADS, HEAD_DIM), qn_b[l]), positions)
        kb = rope(rms_norm(kb.reshape(b, s, WA_KV_HEADS, HEAD_DIM), kn_b[l]), positions)
        vb = vb.reshape(b, s, WA_KV_HEADS, HEAD_DIM)
        ob = windowed_gqa_sink(qb, kb, vb, sink[l])
        o = jnp.concatenate([rms_norm(oa, on_a[l]), rms_norm(ob, on_b[l])], axis=-1)
        x = x + o @ w_out[l]
        h2 = rms_norm(x, ln2_g[l])
        u = depthwise_conv(h2 @ w_up[l], conv_w[l], conv_b[l])
        gate, up = u[..., :D_FF], u[..., D_FF:]
        x = x + (jax.nn.silu(gate) * up) @ w_down[l]
    return x
```

```cpp
#include <hip/hip_runtime.h>
#include <hip/hip_cooperative_groups.h>
#include <cstdio>
#include <cstdint>
namespace cg = cooperative_groups;

#define LAS __attribute__((address_space(3)))
typedef unsigned short bf16_t;
typedef short bf16x8 __attribute__((ext_vector_type(8)));
typedef float f32x4 __attribute__((ext_vector_type(4)));
typedef float f32x16 __attribute__((ext_vector_type(16)));
typedef unsigned u32x4 __attribute__((ext_vector_type(4)));
typedef unsigned u32x2 __attribute__((ext_vector_type(2)));

constexpr int S = 8192, D = 2048, DEPTH = 4, PW = 4608, DFF = 5632, UW = 2 * DFF;
constexpr float EPS = 1e-6f;
constexpr float LOG2E = 1.4426950408889634f;
constexpr float QSCALE = 0.08838834764831845f * LOG2E;
constexpr int NWAVES = 8, NTHREADS = 512;
#ifndef PG8_SP2
#define PG8_SP2 1
#endif
constexpr int LDS_BYTES = 149504 + 256;
constexpr int LDS_CTL = 149504;

constexpr size_t MiB = 1u << 20;
constexpr size_t WS_SSQ = 0;
constexpr size_t WS_WIN = 1 * MiB;
constexpr size_t WS_WOUT = WS_WIN + 72 * MiB;
constexpr size_t WS_WUP = WS_WOUT + 32 * MiB;
constexpr size_t WS_WDN = WS_WUP + 176 * MiB;
constexpr size_t WS_XB = WS_WDN + 89 * MiB;
constexpr size_t WS_PROJ = WS_XB + 33 * MiB;
constexpr size_t WS_VT = WS_PROJ + 72 * MiB;
constexpr size_t WS_ON = WS_VT + 20 * MiB;
constexpr size_t WS_U = WS_ON + 32 * MiB;
constexpr size_t WS_ACT = WS_U + 176 * MiB;
constexpr size_t WS_SSQ2 = WS_ACT + 89 * MiB;
constexpr size_t WS_BAR = WS_SSQ2 + 1 * MiB;
constexpr size_t WS_K2 = WS_BAR + 1 * MiB;
constexpr size_t WS_END = WS_K2 + 20 * MiB;

__device__ __forceinline__ unsigned cvt_pk_bf16(float lo, float hi) { unsigned r; asm volatile("v_cvt_pk_bf16_f32 %0, %1, %2" : "=v"(r) : "v"(lo), "v"(hi)); return r; }
__device__ __forceinline__ float bf2f(bf16_t u) { return __uint_as_float((unsigned)u << 16); }
__device__ __forceinline__ float bflo(unsigned u) { return __uint_as_float(u << 16); }
__device__ __forceinline__ float bfhi(unsigned u) { return __uint_as_float(u & 0xffff0000u); }
__device__ __forceinline__ float shfl_xor_l(float v, int mask, int lane) { return __builtin_bit_cast(float, __builtin_amdgcn_ds_bpermute((lane ^ mask) << 2, __builtin_bit_cast(int, v))); }
__device__ __forceinline__ float wave_sum(float v, int lane) {
#pragma unroll
    for (int o = 1; o < 64; o <<= 1) v += shfl_xor_l(v, o, lane);
    return v;
}

namespace pg8 {
constexpr int BM = 256, BK = 64, HALF = 128, HTB = HALF * BK * 2, NXCD = 8, WGM = 8;
__device__ __forceinline__ int lds_byte(int r, int c) { const int st = (r >> 4) * 2 + (c >> 5), rr = r & 15, cc = c & 31, ob = rr * 64 + cc * 2; return st * 1024 + (ob ^ (((ob >> 9) & 1) << 5)); }
__device__ __forceinline__ void stage_rc(int b, int& R, int& C) { const int st = b / 1024, sb = b % 1024, swz = sb ^ (((sb >> 9) & 1) << 5); R = (st >> 1) * 16 + swz / 64; C = (st & 1) * 32 + (swz % 64) / 2; }
__device__ __forceinline__ int perm32(int rho) { const int n = rho >> 4, i = rho & 15; return 8 * (i >> 2) + 4 * n + (i & 3); }

struct Unit { int pm, pn; };
struct Gemm { const bf16_t* A; const bf16_t* Bt; int M, N, K; int arow_step, arow_off; };

struct StaticOrder {
    int nM, nN, nwg, G, c;
    __device__ void init(int M, int N, int G_, int c_) { nM = M / BM; nN = N / BM; nwg = nM * nN; G = G_; c = c_; }
    __device__ bool next(int i, Unit& u) const {
        const long L = (long)i * G + c; if (L >= nwg) return false;
        int wgid = (int)L; { const int q = nwg / NXCD, r = nwg % NXCD, xcd = wgid % NXCD, off = wgid / NXCD; wgid = (xcd < r ? xcd * (q + 1) : r * (q + 1) + (xcd - r) * q) + off; }
        const int nig = WGM * nN, gid = wgid / nig, fm = gid * WGM, gsz = (nM - fm) < WGM ? (nM - fm) : WGM;
        u.pm = fm + ((wgid % nig) % gsz); u.pn = (wgid % nig) / gsz; return true;
    }
};

template <bool ROPE>
__device__ __forceinline__ void qk_epi(const f32x4 (&acc)[2][2][4][2], int pm, int pn, int wr, int wc, int fr, int fq, const LAS float* rstab, LAS float* P,
                                       const float* nw, bool isq, bool isk, int kh0, bf16_t* proj, bf16_t* K2, const int* positions) {
    const int ln = (fq << 4) | fr;
#pragma unroll
    for (int ai = 0; ai < 2; ++ai)
#pragma unroll
        for (int m = 0; m < 4; ++m) {
            const int rl = ai * HALF + wr * 64 + m * 16 + fr;
            const float rs = rstab[rl];
#pragma unroll
            for (int bj = 0; bj < 2; ++bj) {
                const f32x4 a0 = acc[ai][bj][m][0] * rs, a1 = acc[ai][bj][m][1] * rs;
                float sq = ((a0[0] * a0[0] + a0[1] * a0[1]) + (a0[2] * a0[2] + a0[3] * a0[3])) + ((a1[0] * a1[0] + a1[1] * a1[1]) + (a1[2] * a1[2] + a1[3] * a1[3]));
                sq += shfl_xor_l(sq, 16, ln); sq += shfl_xor_l(sq, 32, ln);
                P[(rl * 2 + bj) * 4 + wc] = sq;
            }
        }
    asm volatile("s_waitcnt lgkmcnt(0)" ::: "memory"); __builtin_amdgcn_s_barrier(); asm volatile("" ::: "memory");
    const int blk = 4 * wc + fq, p0 = 8 * blk;
    f32x4 wv[2]; float invf[4];
#pragma unroll
    for (int n = 0; n < 2; ++n) wv[n] = ROPE ? *(const f32x4*)(nw + 64 * n + 4 * blk) : *(const f32x4*)(nw + p0 + 4 * n);
#pragma unroll
    for (int j = 0; j < 4; ++j) invf[j] = __builtin_amdgcn_exp2f(-(float)(4 * blk + j) * (2.0f / 128.0f) * 13.287712379549449f);
    const float qs = isq ? QSCALE : 1.0f;
#pragma unroll
    for (int ai = 0; ai < 2; ++ai)
#pragma unroll
        for (int m = 0; m < 4; ++m) {
            asm volatile("" ::: "memory");
            const int rl = ai * HALF + wr * 64 + m * 16 + fr, row = pm * BM + rl;
            const float rs = rstab[rl] * qs;
            f32x4 cs, sn;
            if (ROPE) {
                const float pos = (float)positions[row];
#pragma unroll
                for (int j = 0; j < 4; ++j) { const float ang = pos * invf[j]; double rev = (double)ang * 0.15915494309189535; rev -= __builtin_rint(rev); const float rf = (float)rev;
                    cs[j] = __builtin_amdgcn_cosf(rf); sn[j] = __builtin_amdgcn_sinf(rf); }
            }
            const int kblk = 8 * pm + 4 * ai + 2 * wr + (m >> 1), tl = 16 * (m & 1) + fr;
#pragma unroll
            for (int bj = 0; bj < 2; ++bj) {
                const f32x4 part = *(const LAS f32x4*)(P + (rl * 2 + bj) * 4);
                const float hr = __builtin_amdgcn_rsqf(((part[0] + part[1]) + (part[2] + part[3])) * (1.0f / 128.0f) + EPS) * rs;
                f32x4 y0 = acc[ai][bj][m][0] * hr * wv[0], y1 = acc[ai][bj][m][1] * hr * wv[1];
                if (ROPE) { const f32x4 o0 = y0 * cs - y1 * sn, o1 = y1 * cs + y0 * sn; y0 = o0; y1 = o1; }
                u32x4 w; w.x = cvt_pk_bf16(y0[0], y0[1]); w.y = cvt_pk_bf16(y0[2], y0[3]); w.z = cvt_pk_bf16(y1[0], y1[1]); w.w = cvt_pk_bf16(y1[2], y1[3]);
                bf16_t* qa_ = proj + (size_t)row * PW + pn * BM + bj * HALF + p0;
                bf16_t* ka_ = K2 + ((size_t)(((kh0 + bj) * 256 + kblk) * 8 + (blk >> 1)) * 64 + (blk & 1) * 32 + tl) * 8;
                *(u32x4*)(isk ? ka_ : qa_) = w;
            }
        }
}
__device__ __forceinline__ void v_epi(const f32x4 (&acc)[2][2][4][2], int pm, int wr, int wc, int fr, int fq, const LAS float* rstab, int vh0, bf16_t* V2, LAS bf16_t* T) {
    const int ln = (fq << 4) | fr, dl = ln & 31, hi2 = ln >> 5;
    LAS bf16_t* wp = T + fr * 40 + 8 * fq;
    const LAS bf16_t* rp = T + (4 * hi2) * 40 + dl;
#pragma unroll
    for (int ai = 0; ai < 2; ++ai)
#pragma unroll
        for (int m = 0; m < 4; ++m) {
            const int rl = ai * HALF + wr * 64 + m * 16 + fr;
            const float rs = rstab[rl];
            const int kblk = 8 * pm + 4 * ai + 2 * wr + (m >> 1);
#pragma unroll
            for (int bj = 0; bj < 2; ++bj) {
                const f32x4 v0 = acc[ai][bj][m][0] * rs, v1 = acc[ai][bj][m][1] * rs;
                u32x4 w; w.x = cvt_pk_bf16(v0[0], v0[1]); w.y = cvt_pk_bf16(v0[2], v0[3]); w.z = cvt_pk_bf16(v1[0], v1[1]); w.w = cvt_pk_bf16(v1[2], v1[3]);
                *(LAS u32x4*)wp = w;
                asm volatile("s_waitcnt lgkmcnt(0)" ::: "memory");
                u32x4 o;
                o.x = (unsigned)rp[0 * 40] | ((unsigned)rp[1 * 40] << 16); o.y = (unsigned)rp[2 * 40] | ((unsigned)rp[3 * 40] << 16);
                o.z = (unsigned)rp[8 * 40] | ((unsigned)rp[9 * 40] << 16); o.w = (unsigned)rp[10 * 40] | ((unsigned)rp[11 * 40] << 16);
                asm volatile("s_waitcnt lgkmcnt(0)" ::: "memory");
                *(u32x4*)(V2 + ((size_t)((((vh0 + bj) * 256 + kblk) * 4 + wc) * 2 + (m & 1)) * 64 + ln) * 8) = o;
            }
        }
}

template <bool F32OUT>
__device__ __forceinline__ void res_epi(const f32x4 (&acc)[2][2][4][2], int pm, int pn, int wr, int wc, int fr, int fq, bf16_t* xb, float* xout, float* ssq_next) {
    const int row0 = pm * BM + wr * 64 + fr, col0 = pn * BM + wc * 32 + 8 * fq, ln = (fq << 4) | fr;
#pragma unroll
    for (int ai = 0; ai < 2; ++ai) {
#pragma unroll
        for (int m = 0; m < 4; ++m) {
            const int row = row0 + ai * HALF + m * 16;
            const size_t off = (size_t)row * D + col0;
            u32x4 r[2];
#pragma unroll
            for (int bj = 0; bj < 2; ++bj) r[bj] = *(const u32x4*)(xb + off + bj * HALF);
            float s = 0.f;
#pragma unroll
            for (int bj = 0; bj < 2; ++bj) {
                f32x4 v0 = acc[ai][bj][m][0], v1 = acc[ai][bj][m][1];
                v0[0] += bflo(r[bj].x); v0[1] += bfhi(r[bj].x); v0[2] += bflo(r[bj].y); v0[3] += bfhi(r[bj].y);
                v1[0] += bflo(r[bj].z); v1[1] += bfhi(r[bj].z); v1[2] += bflo(r[bj].w); v1[3] += bfhi(r[bj].w);
                if (F32OUT) { *(f32x4*)(xout + off + bj * HALF) = v0; *(f32x4*)(xout + off + bj * HALF + 4) = v1; }
                s += ((v0[0] * v0[0] + v0[1] * v0[1]) + (v0[2] * v0[2] + v0[3] * v0[3])) + ((v1[0] * v1[0] + v1[1] * v1[1]) + (v1[2] * v1[2] + v1[3] * v1[3]));
                u32x4 w; w.x = cvt_pk_bf16(v0[0], v0[1]); w.y = cvt_pk_bf16(v0[2], v0[3]); w.z = cvt_pk_bf16(v1[0], v1[1]); w.w = cvt_pk_bf16(v1[2], v1[3]);
                *(u32x4*)(xb + off + bj * HALF) = w;
            }
            s += shfl_xor_l(s, 16, ln); s += shfl_xor_l(s, 32, ln);
            ssq_next[(size_t)row * 32 + pn * 4 + wc] = s;
            if (m & 1) asm volatile("" ::: "memory");
        }
    }
}

struct Epi {
    int mode;
    bf16_t* O; int ldc; const float* ssq;
    const float* xin; float* xout; bf16_t* xb; float* ssq_next;
    bf16_t* K2; bf16_t* V2; const int* positions; const float* nqa; const float* nka; const float* nqb; const float* nkb;
    const float* cw; const float* cbv; float* Ub;
    __device__ __forceinline__ void operator()(const f32x4 (&acc)[2][2][4][2], const Unit& u, int wr, int wc, int fr, int fq, const LAS float* rstab, LAS float* X, const LAS float* wtab) const {
        const int row0 = u.pm * BM + wr * 64 + fr;
        if (mode == 2) {
            const int cl0 = wc * 32 + 8 * fq;
#pragma unroll
            for (int ai = 0; ai < 2; ++ai) {
                const int q = 2 * ai + wr;
                float rs0 = rstab[wr * 64 + fr + ai * HALF], rs3 = rstab[wr * 64 + fr + ai * HALF + 48];
                asm volatile("" : "+v"(rs0), "+v"(rs3));
                if (fr == 0) {
#pragma unroll
                    for (int bj = 0; bj < 2; ++bj)
#pragma unroll
                        for (int n = 0; n < 2; ++n) *(LAS f32x4*)(X + ((q * 2 + 0) * 2 + bj) * 128 + cl0 + 4 * n) = acc[ai][bj][0][n] * rs0;
                }
                if (fr == 15) {
#pragma unroll
                    for (int bj = 0; bj < 2; ++bj)
#pragma unroll
                        for (int n = 0; n < 2; ++n) *(LAS f32x4*)(X + ((q * 2 + 1) * 2 + bj) * 128 + cl0 + 4 * n) = acc[ai][bj][3][n] * rs3;
                }
            }
            asm volatile("s_waitcnt lgkmcnt(0)" ::: "memory"); __builtin_amdgcn_s_barrier(); asm volatile("" ::: "memory");
            const int chg = u.pn * HALF + cl0;
#pragma unroll
            for (int ai = 0; ai < 2; ++ai) {
                asm volatile("" ::: "memory");
                const int q = 2 * ai + wr;
                float rs[4];
#pragma unroll
                for (int m = 0; m < 4; ++m) rs[m] = rstab[wr * 64 + fr + ai * HALF + m * 16];
                u32x2 lo[4];
#pragma unroll
                for (int n = 0; n < 2; ++n) {
                    float G[4][4];
#pragma unroll
                    for (int bj = 0; bj < 2; ++bj) {
                        asm volatile("" ::: "memory");
                        f32x4 wt[4];
                        { const LAS float* wp_ = wtab + bj * HALF + cl0 + 4 * n; wt[0] = *(const LAS f32x4*)wp_; wt[1] = *(const LAS f32x4*)(wp_ + 256); wt[2] = *(const LAS f32x4*)(wp_ + 512); wt[3] = *(const LAS f32x4*)(wp_ + 768); }
                        const f32x4 Bp = *(const LAS f32x4*)(X + (((q > 0 ? q - 1 : 0) * 2 + 1) * 2 + bj) * 128 + cl0 + 4 * n);
                        const f32x4 Bn = *(const LAS f32x4*)(X + (((q < 3 ? q + 1 : 3) * 2 + 0) * 2 + bj) * 128 + cl0 + 4 * n);
#pragma unroll
                        for (int j = 0; j < 4; ++j) {
                            __builtin_amdgcn_sched_barrier(0);
                            float V[4], P[4], N[4];
#pragma unroll
                            for (int m = 0; m < 4; ++m) { V[m] = acc[ai][bj][m][n][j] * rs[m];
                                P[m] = __builtin_bit_cast(float, __builtin_amdgcn_mov_dpp(__builtin_bit_cast(int, V[m]), 0x121, 0xf, 0xf, true));
                                N[m] = __builtin_bit_cast(float, __builtin_amdgcn_mov_dpp(__builtin_bit_cast(int, V[m]), 0x12F, 0xf, 0xf, true)); }
#pragma unroll
                            for (int m = 0; m < 4; ++m) {
                                const float pv = (fr > 0) ? P[m] : ((m > 0) ? P[m > 0 ? m - 1 : 0] : Bp[j]);
                                const float nv = (fr < 15) ? N[m] : ((m < 3) ? N[m < 3 ? m + 1 : 3] : Bn[j]);
                                const float cvv = wt[0][j] * pv + wt[1][j] * V[m] + wt[2][j] * nv + wt[3][j];
                                if (bj == 0) G[m][j] = cvv;
                                else { const float g = G[m][j]; G[m][j] = g * __builtin_amdgcn_rcpf(1.0f + __builtin_amdgcn_exp2f(-g * LOG2E)) * cvv; }
                            }
                        }
                    }
#pragma unroll
                    for (int m = 0; m < 4; ++m) {
                        const int rl = ai * HALF + wr * 64 + m * 16 + fr;
                        u32x2 ov; ov.x = cvt_pk_bf16(G[m][0], G[m][1]); ov.y = cvt_pk_bf16(G[m][2], G[m][3]);
                        if (n == 0) lo[m] = ov;
                        else { u32x4 o4; o4.x = lo[m].x; o4.y = lo[m].y; o4.z = ov.x; o4.w = ov.y;
                            const int grow = u.pm * 254 - 1 + rl; const int rsel = ((rl >= 1) && (rl <= 254) && (grow < S)) ? grow : S;
                            bf16_t* dst = O + (size_t)rsel * ldc + chg;
                            *(u32x4*)dst = o4; }
                    }
                }
            }
        } else if (mode == 0) {
            const int pn = u.pn;
            if ((pn >= 8 && pn < 12) || pn == 17) v_epi(acc, u.pm, wr, wc, fr, fq, rstab, (pn == 17) ? 8 : 2 * (pn - 8), V2, (LAS bf16_t*)X + (wr * 4 + wc) * 640);
            else if (pn >= 12) qk_epi<true>(acc, u.pm, pn, wr, wc, fr, fq, rstab, X, (pn == 16) ? nkb : nqb, pn != 16, pn == 16, 8, O, K2, positions);
            else qk_epi<false>(acc, u.pm, pn, wr, wc, fr, fq, rstab, X, (pn < 4) ? nqa : nka, pn < 4, pn >= 4, 2 * (pn - 4), O, K2, positions);
        } else if (mode == 3) {
            res_epi<true>(acc, u.pm, u.pn, wr, wc, fr, fq, xb, xout, ssq_next);
        } else {
            res_epi<false>(acc, u.pm, u.pn, wr, wc, fr, fq, xb, xout, ssq_next);
        }
    }
};

__device__ __forceinline__ void gemm_phase(LAS unsigned char* lds, const Gemm g, const StaticOrder& S_, const Epi& E, const int tid) {
    const int wid = __builtin_amdgcn_readfirstlane(tid >> 6), lane = tid & 63, wr = wid >> 2, wc = wid & 3, fr = lane & 15, fq = lane >> 4;
    const int K = g.K, nt = K / BK;
    unsigned voffA[2], voffB[2];
#pragma unroll
    for (int i = 0; i < 2; ++i) { int R, C; stage_rc(tid * 16 + i * 8192, R, C); const int Rb = (R & ~31) + perm32(R & 31);
        voffA[i] = (unsigned)(R * K + C) * 2u; voffB[i] = (unsigned)(Rb * K + C) * 2u; }
    const size_t kstep = (size_t)(BK * 2);
    const size_t hstep = (size_t)HALF * K * 2;
    const size_t tstep = 2 * hstep;
    const unsigned ldsw = (unsigned)wid * 1024u;
    const int aoff = lds_byte(wr * 64 + fr, fq * 8), boff = lds_byte(wc * 32 + fr, fq * 8);
#define PG8_SA(b, h) (((b) * 2 + (h)) * HTB)
#define PG8_SB(b, h) ((4 + (b) * 2 + (h)) * HTB)
#define PG8_STAGE(bufoff, gbase, voff) do { _Pragma("unroll") for (int _i = 0; _i < 2; ++_i) \
        __builtin_amdgcn_global_load_lds((const unsigned*)((const char*)(gbase) + (voff)[_i]), (LAS unsigned*)(lds + (bufoff) + ldsw + _i * 8192), 16, 0, 0); } while (0)
#define PG8_LDA(dst, b, h) do { _Pragma("unroll") for (int m = 0; m < 4; ++m) _Pragma("unroll") for (int k = 0; k < 2; ++k) dst[m][k] = *(const LAS bf16x8*)(lds + PG8_SA(b, h) + aoff + m * 2048 + k * 1024); } while (0)
#define PG8_LDB(dst, b, h) do { _Pragma("unroll") for (int n = 0; n < 2; ++n) _Pragma("unroll") for (int k = 0; k < 2; ++k) dst[n][k] = *(const LAS bf16x8*)(lds + PG8_SB(b, h) + boff + n * 2048 + k * 1024); } while (0)
#define PG8_MMA(ai, bj, At, Bt) do { __builtin_amdgcn_s_setprio(1); _Pragma("unroll") for (int m = 0; m < 4; ++m) _Pragma("unroll") for (int n = 0; n < 2; ++n) _Pragma("unroll") for (int k = 0; k < 2; ++k) \
        acc[ai][bj][m][n] = __builtin_amdgcn_mfma_f32_16x16x32_bf16(Bt[n][k], At[m][k], acc[ai][bj][m][n], 0, 0, 0); __builtin_amdgcn_s_setprio(0); } while (0)
#define PG8_WAIT_V(n) asm volatile("s_waitcnt vmcnt(" #n ")" ::: "memory")
#define PG8_WAIT_L(n) asm volatile("s_waitcnt lgkmcnt(" #n ")" ::: "memory")
#define PG8_BAR __builtin_amdgcn_s_barrier()
#define PG8_SCHED __builtin_amdgcn_sched_barrier(0)
    Unit cur, nxt; int ui = 0;
    if (!S_.next(0, cur)) return;
    f32x4 acc[2][2][4][2];
#pragma unroll
    for (int a = 0; a < 2; ++a)
#pragma unroll
        for (int b = 0; b < 2; ++b)
#pragma unroll
            for (int m = 0; m < 4; ++m)
#pragma unroll
                for (int n = 0; n < 2; ++n) acc[a][b][m][n] = (f32x4){0.f, 0.f, 0.f, 0.f};
    bf16x8 At[4][2], B0[2][2], B1[2][2];
    const long astep = (long)g.arow_step * K * 2, aoff0 = (long)g.arow_off * K * 2;
    const char* cA = (const char*)g.A + (long)cur.pm * astep + aoff0; const char* cB = (const char*)g.Bt + (size_t)cur.pn * tstep;
    LAS float* rstab = (LAS float*)(lds + 8 * HTB);
#define PG8_RSTAB(unit, par) do { int tr_ = tid; asm volatile("" : "+v"(tr_)); if ((E.mode == 0 || E.mode == 2) && tr_ < 256) { const int gr_ = (unit).pm * g.arow_step + g.arow_off + tr_; const bool ok_ = gr_ >= 0 && gr_ < g.M; const f32x4* sp_ = (const f32x4*)(E.ssq + (size_t)(ok_ ? gr_ : 0) * 32); f32x4 t4_ = sp_[0]; \
        _Pragma("unroll") for (int q_ = 1; q_ < 8; ++q_) t4_ = t4_ + sp_[q_]; \
        rstab[(par) * 256 + tr_] = ok_ ? __builtin_amdgcn_rsqf(((t4_[0] + t4_[1]) + (t4_[2] + t4_[3])) * (1.0f / D) + EPS) : 0.f;     \
        if (E.mode == 2) { const int c_ = (unit).pn * HALF + (tr_ & 127) + (tr_ >> 7) * DFF; LAS float* wt_ = rstab + 2560 + (par) * 1024 + tr_;     \
            wt_[0] = E.cw[c_]; wt_[256] = E.cw[UW + c_]; wt_[512] = E.cw[2 * UW + c_]; wt_[768] = E.cbv[c_]; } } } while (0)
#if PG8_SP2
    PG8_STAGE(PG8_SB(0, 0), cB, voffB); PG8_STAGE(PG8_SB(0, 1), cB + hstep, voffB); PG8_STAGE(PG8_SA(0, 0), cA, voffA); PG8_STAGE(PG8_SA(0, 1), cA + hstep, voffA);
    PG8_RSTAB(cur, 0);
    if (wr == 1) PG8_BAR;
    PG8_WAIT_V(2); PG8_BAR;
    PG8_STAGE(PG8_SB(1, 0), cB + kstep, voffB); PG8_STAGE(PG8_SA(1, 0), cA + kstep, voffA); PG8_STAGE(PG8_SB(1, 1), cB + hstep + kstep, voffB);
    PG8_WAIT_V(6); PG8_BAR;
#else
    PG8_STAGE(PG8_SB(0, 0), cB, voffB); PG8_STAGE(PG8_SA(0, 0), cA, voffA); PG8_STAGE(PG8_SB(0, 1), cB + hstep, voffB); PG8_STAGE(PG8_SA(0, 1), cA + hstep, voffA);
    if (wr == 1) PG8_BAR;
    PG8_WAIT_V(4); PG8_BAR;
    PG8_STAGE(PG8_SB(1, 0), cB + kstep, voffB); PG8_STAGE(PG8_SA(1, 0), cA + kstep, voffA); PG8_STAGE(PG8_SB(1, 1), cB + hstep + kstep, voffB);
    PG8_WAIT_V(6); PG8_BAR;
#endif
    for (;;) {
        const bool has_next = S_.next(ui + 1, nxt);
        const char* nA = has_next ? (const char*)g.A + (long)nxt.pm * astep + aoff0 : cA; const char* nB = has_next ? (const char*)g.Bt + (size_t)nxt.pn * tstep : cB;
        for (int t = 0; t < nt; t += 2) {
            const bool last = (t == nt - 2);
            const char* a1 = cA + (size_t)(t + 1) * kstep;
            const char* a2 = last ? nA : cA + (size_t)(t + 2) * kstep; const char* b2 = last ? nB : cB + (size_t)(t + 2) * kstep;
            const char* a3 = a2 + kstep; const char* b3 = b2 + kstep;
#if PG8_SP2
            PG8_LDB(B0, 0, 0); PG8_LDB(B1, 0, 1); PG8_SCHED; PG8_LDA(At, 0, 0); PG8_STAGE(PG8_SA(1, 1), a1 + hstep, voffA);
            PG8_WAIT_V(8); PG8_WAIT_L(0); PG8_BAR; PG8_MMA(0, 0, At, B0); PG8_MMA(0, 1, At, B1); PG8_BAR; PG8_SCHED;
            PG8_LDA(At, 0, 1); PG8_STAGE(PG8_SB(0, 0), b2, voffB); PG8_STAGE(PG8_SB(0, 1), b2 + hstep, voffB); PG8_STAGE(PG8_SA(0, 0), a2, voffA);
            PG8_WAIT_V(8); PG8_WAIT_L(0); PG8_BAR; PG8_MMA(1, 0, At, B0); PG8_MMA(1, 1, At, B1); PG8_BAR; PG8_SCHED;
            PG8_LDB(B0, 1, 0); PG8_LDB(B1, 1, 1); PG8_SCHED; PG8_LDA(At, 1, 0); PG8_STAGE(PG8_SA(0, 1), a2 + hstep, voffA);
            PG8_WAIT_V(8); PG8_WAIT_L(0); PG8_BAR; PG8_MMA(0, 0, At, B0); PG8_MMA(0, 1, At, B1); PG8_BAR; PG8_SCHED;
            PG8_LDA(At, 1, 1); PG8_STAGE(PG8_SB(1, 0), b3, voffB); PG8_STAGE(PG8_SB(1, 1), b3 + hstep, voffB); PG8_STAGE(PG8_SA(1, 0), a3, voffA);
            PG8_WAIT_V(8); PG8_WAIT_L(0); PG8_BAR; PG8_MMA(1, 0, At, B0); PG8_MMA(1, 1, At, B1); PG8_BAR; PG8_SCHED;
        #else
            PG8_LDB(B0, 0, 0); PG8_SCHED; PG8_LDA(At, 0, 0); PG8_STAGE(PG8_SA(1, 1), a1 + hstep, voffA);
            PG8_WAIT_L(8); PG8_BAR; PG8_WAIT_L(0); PG8_MMA(0, 0, At, B0); PG8_BAR; PG8_SCHED;
            PG8_LDB(B1, 0, 1); PG8_STAGE(PG8_SB(0, 0), b2, voffB);
            PG8_BAR; PG8_WAIT_L(0); PG8_MMA(0, 1, At, B1); PG8_BAR;
            PG8_LDA(At, 0, 1); PG8_STAGE(PG8_SA(0, 0), a2, voffA);
            PG8_BAR; PG8_WAIT_L(0); PG8_MMA(1, 0, At, B0); PG8_BAR; PG8_SCHED;
            PG8_STAGE(PG8_SB(0, 1), b2 + hstep, voffB);
            PG8_WAIT_V(6); PG8_BAR; PG8_MMA(1, 1, At, B1); PG8_BAR;
            PG8_LDB(B0, 1, 0); PG8_SCHED; PG8_LDA(At, 1, 0); PG8_STAGE(PG8_SA(0, 1), a2 + hstep, voffA);
            PG8_WAIT_L(8); PG8_BAR; PG8_WAIT_L(0); PG8_MMA(0, 0, At, B0); PG8_BAR; PG8_SCHED;
            PG8_LDB(B1, 1, 1); PG8_STAGE(PG8_SB(1, 0), b3, voffB);
            PG8_BAR; PG8_WAIT_L(0); PG8_MMA(0, 1, At, B1); PG8_BAR;
            PG8_LDA(At, 1, 1); PG8_STAGE(PG8_SA(1, 0), a3, voffA);
            PG8_BAR; PG8_WAIT_L(0); PG8_MMA(1, 0, At, B0); PG8_BAR; PG8_SCHED;
            PG8_STAGE(PG8_SB(1, 1), b3 + hstep, voffB);
            PG8_WAIT_V(6); PG8_BAR; PG8_MMA(1, 1, At, B1); PG8_BAR;
#endif
}
        if (wr == 0) PG8_BAR;
        { int t_e = tid; asm volatile("" : "+v"(t_e)); const int fr_e = t_e & 15, fq_e = (t_e >> 4) & 3;
          E(acc, cur, wr, wc, fr_e, fq_e, rstab + (ui & 1) * 256, rstab + 512, rstab + 2560 + (ui & 1) * 1024); }
        if (!has_next) break;
#pragma unroll
        for (int a = 0; a < 2; ++a)
#pragma unroll
            for (int b = 0; b < 2; ++b)
#pragma unroll
                for (int m = 0; m < 4; ++m)
#pragma unroll
                    for (int n = 0; n < 2; ++n) acc[a][b][m][n] = (f32x4){0.f, 0.f, 0.f, 0.f};
        cur = nxt; cA = nA; cB = nB; ++ui;
        PG8_RSTAB(cur, ui & 1);
        if (wr == 1) PG8_BAR;
    }
    PG8_WAIT_V(0);
    PG8_BAR;
#undef PG8_SA
#undef PG8_SB
#undef PG8_STAGE
#undef PG8_LDA
#undef PG8_LDB
#undef PG8_MMA
#undef PG8_WAIT_V
#undef PG8_WAIT_L
#undef PG8_BAR
#undef PG8_SCHED
#undef PG8_RSTAB
}
}

__device__ __forceinline__ void transpose_item(const float* W, int K, int N, const float* g0, const float* g1, bf16_t* WT, LAS unsigned* T, int item, int lane, bool gate_up_interleave = false, bool rope_heads = false) {
    constexpr int PD = 36;
    const int nblk = N / 128, kb = item / nblk, nb = item % nblk, k0 = 64 * kb, n0 = 128 * nb;
    const float* gp = g0 ? (k0 < 1024 ? g0 + k0 : g1 + (k0 - 1024)) : nullptr;
    const int dn0 = gate_up_interleave ? ((nb < DFF / 128) ? 256 * nb : 256 * (nb - DFF / 128) + 128) : n0;
    const int l31 = lane & 31, kh = (lane >> 5) * 2;
    const float* wp = W + (size_t)(k0 + kh) * N + n0 + 4 * l31;
#pragma unroll 4
    for (int i = 0; i < 16; ++i) {
        const int kk = 4 * i + kh;
        f32x4 va = __builtin_nontemporal_load((const f32x4*)(wp + (size_t)(4 * i) * N)), vb = __builtin_nontemporal_load((const f32x4*)(wp + (size_t)(4 * i + 1) * N));
        if (gp) { va = va * gp[kk]; vb = vb * gp[kk + 1]; }
#pragma unroll
        for (int e = 0; e < 4; ++e) T[(4 * l31 + e) * PD + (kk >> 1)] = cvt_pk_bf16(va[e], vb[e]);
    }
    asm volatile("s_waitcnt lgkmcnt(0)" ::: "memory");
    const int c = lane & 7;
#pragma unroll 4
    for (int it = 0; it < 16; ++it) {
        const int n = 8 * it + (lane >> 3);
        const u32x4 o = *(const LAS u32x4*)(T + n * PD + 4 * c);
        const int nd = (rope_heads && nb >= 24 && nb < 34) ? ((n < 64) ? (8 * (n >> 2) + (n & 3)) : (8 * ((n - 64) >> 2) + 4 + (n & 3))) : n;
        *(u32x4*)(WT + (size_t)(dn0 + nd) * K + k0 + 8 * c) = o;
    }
    asm volatile("s_waitcnt lgkmcnt(0)" ::: "memory");
}

__device__ __forceinline__ void attn_finish(f32x16 (&o)[4], float l, LAS float* red, int w, int lane, bf16_t* outp  ) {
    const int ql = lane & 31, hi = lane >> 5;
    const float lt = l + shfl_xor_l(l, 32, lane);
    const float inv = 1.0f / lt;
    float ss = 0.f;
#pragma unroll
    for (int db = 0; db < 4; ++db)
#pragma unroll
        for (int i = 0; i < 16; ++i) { o[db][i] *= inv; ss += o[db][i] * o[db][i]; }
    ss += shfl_xor_l(ss, 32, lane);
    if (hi == 0) red[w * 32 + ql] = ss;
    __syncthreads();
    float tot = 0.f;
#pragma unroll
    for (int w2 = 0; w2 < 8; ++w2) tot += red[w2 * 32 + ql];
    const float rstd = __builtin_amdgcn_rsqf(tot * (1.0f / 1024.0f) + EPS);
#pragma unroll
    for (int db = 0; db < 4; ++db)
#pragma unroll
        for (int gp = 0; gp < 2; ++gp) {
            u32x2 a, b;
            a.x = cvt_pk_bf16(o[db][8 * gp + 0] * rstd, o[db][8 * gp + 1] * rstd); a.y = cvt_pk_bf16(o[db][8 * gp + 2] * rstd, o[db][8 * gp + 3] * rstd);
            b.x = cvt_pk_bf16(o[db][8 * gp + 4] * rstd, o[db][8 * gp + 5] * rstd); b.y = cvt_pk_bf16(o[db][8 * gp + 6] * rstd, o[db][8 * gp + 7] * rstd);
            const unsigned sx = hi ? a.x : b.x, sy = hi ? a.y : b.y;
            const unsigned rx = __builtin_amdgcn_ds_bpermute((lane ^ 32) << 2, (int)sx), ry = __builtin_amdgcn_ds_bpermute((lane ^ 32) << 2, (int)sy);
            u32x4 w4;
            if (hi == 0) { w4.x = a.x; w4.y = a.y; w4.z = rx; w4.w = ry; } else { w4.x = rx; w4.y = ry; w4.z = b.x; w4.w = b.y; }
            *(u32x4*)(outp + 32 * db + 16 * gp + 8 * hi) = w4;
        }
}

template <bool NA>
__device__ __forceinline__ void attn_unit(const bf16_t* qp, const bf16_t* kp, const bf16_t* vp, int lo, int nblk, int tq, int r, int qc, const LAS float* rpl, float m, float l,
                                          LAS float* red, int w, int lane, bf16_t* outp) {
    const int hi = lane >> 5;
    bf16x8 qf[8], kf[8], vf[8];
#pragma unroll
    for (int c = 0; c < 8; ++c) qf[c] = *(const bf16x8*)(qp + 16 * c);
#pragma unroll
    for (int c = 0; c < 8; ++c) kf[c] = *(const bf16x8*)(kp + 512 * c);
#pragma unroll
    for (int c = 0; c < 8; ++c) vf[c] = *(const bf16x8*)(vp + 512 * c);
    f32x16 o[4];
#pragma unroll
    for (int db = 0; db < 4; ++db)
#pragma unroll
        for (int i = 0; i < 16; ++i) o[db][i] = 0.f;
    const int cs = min(max(qc - 8, 0), 48);
#pragma unroll 1
    for (int n = 0; n < nblk; ++n) {
        const int adv = (n + 1 < nblk) ? 4096 : 0;
        f32x16 s;
#pragma unroll
        for (int i = 0; i < 16; ++i) s[i] = 0.f;
#pragma unroll
        for (int c = 0; c < 8; ++c) s = __builtin_amdgcn_mfma_f32_32x32x16_bf16(kf[c], qf[c], s, 0, 0, 0);
        __builtin_amdgcn_sched_barrier(0);
        kp += adv;
#pragma unroll
        for (int c = 0; c < 8; ++c) kf[c] = *(const bf16x8*)(kp + 512 * c);
        __builtin_amdgcn_sched_barrier(0);
        const int kblk = lo + n;
        if (NA) {
            const int krow = kblk >> 1, kc0 = 32 * (kblk & 1) + 4 * hi;
            const LAS float* rpr = rpl + (krow - r + 7) * 31 + (kc0 - qc + 15);
            const int vb = kc0 - cs;
            float bias[16];
#pragma unroll
            for (int i = 0; i < 16; ++i) bias[i] = rpr[8 * (i >> 2) + (i & 3)];
#pragma unroll
            for (int i = 0; i < 16; ++i) asm volatile("" : "+v"(bias[i]));
#pragma unroll
            for (int i = 0; i < 16; ++i) {
                const int off = 8 * (i >> 2) + (i & 3);
                s[i] = ((unsigned)(vb + off) < 16u) ? (s[i] + bias[i]) : -INFINITY;
            }
        } else if (kblk - (tq >> 5) == -4 || kblk - (tq >> 5) == 4) {
            const int k0 = kblk * 32 + 4 * hi - tq;
#pragma unroll
            for (int i = 0; i < 16; ++i) { const int dlt = k0 + 8 * (i >> 2) + (i & 3); s[i] = (dlt >= -128 && dlt <= 128) ? s[i] : -INFINITY; }
        }
        float mx = fmaxf(fmaxf(fmaxf(s[0], s[1]), fmaxf(s[2], s[3])), fmaxf(fmaxf(s[4], s[5]), fmaxf(s[6], s[7])));
        mx = fmaxf(mx, fmaxf(fmaxf(fmaxf(s[8], s[9]), fmaxf(s[10], s[11])), fmaxf(fmaxf(s[12], s[13]), fmaxf(s[14], s[15]))));
        mx = fmaxf(mx, shfl_xor_l(mx, 32, lane));
        const float mn = fmaxf(m, mx);
        if (__builtin_amdgcn_ballot_w64(mn > m) != 0ull) {
            const float alpha = __builtin_amdgcn_exp2f(m - mn);
            l *= alpha;
#pragma unroll
            for (int db = 0; db < 4; ++db) o[db] = o[db] * alpha;
            m = mn;
        }
        float sum = 0.f;
#pragma unroll
        for (int i = 0; i < 16; ++i) { s[i] = __builtin_amdgcn_exp2f(s[i] - m); sum += s[i]; }
        l += sum;
        bf16x8 pf[2];
#pragma unroll
        for (int j = 0; j < 2; ++j) {
            u32x4 wv; wv.x = cvt_pk_bf16(s[8 * j + 0], s[8 * j + 1]); wv.y = cvt_pk_bf16(s[8 * j + 2], s[8 * j + 3]); wv.z = cvt_pk_bf16(s[8 * j + 4], s[8 * j + 5]); wv.w = cvt_pk_bf16(s[8 * j + 6], s[8 * j + 7]);
            pf[j] = __builtin_bit_cast(bf16x8, wv);
        }
#pragma unroll
        for (int db = 0; db < 4; ++db)
#pragma unroll
            for (int j = 0; j < 2; ++j) o[db] = __builtin_amdgcn_mfma_f32_32x32x16_bf16(vf[db * 2 + j], pf[j], o[db], 0, 0, 0);
        __builtin_amdgcn_sched_barrier(0);
        vp += adv;
#pragma unroll
        for (int c = 0; c < 8; ++c) vf[c] = *(const bf16x8*)(vp + 512 * c);
        __builtin_amdgcn_sched_barrier(0);
    }
    attn_finish(o, l, red, w, lane, outp);
}

#define XB_TMO      128
#define XB_XCNT(j)  (256  + 64 * (j))
#define XB_XSUB(j)  (1280 + 64 * (j))
#define XB_XGEN(j)  (2304 + 64 * (j))
#define XB_TOP      3328
#define XB_TOPGEN   3392
#define XCD_BAR_WORDS 3456
#define XB_SPIN_CAP (1u << 18)

__device__ __forceinline__ unsigned xb_ld(unsigned* p)              { return __hip_atomic_load(p, __ATOMIC_RELAXED, __HIP_MEMORY_SCOPE_AGENT); }
__device__ __forceinline__ unsigned xb_add(unsigned* p, unsigned v) { return __hip_atomic_fetch_add(p, v, __ATOMIC_RELAXED, __HIP_MEMORY_SCOPE_AGENT); }
__device__ __forceinline__ unsigned xb_xcc_id() { return (unsigned)__builtin_amdgcn_s_getreg((3 << 11) | 20) & 0xFu; }
#define XB_SPIN(cond, bar) do { unsigned _sp = 0; while (cond) { __builtin_amdgcn_s_sleep(1); \
    if ((++_sp & 255u) == 0u) { if (xb_ld(&(bar)[XB_TMO])) break; if (_sp > XB_SPIN_CAP) { atomicAdd(&(bar)[XB_TMO], 1u); break; } } } } while (0)

struct XcdBarrier {
    unsigned* bar; unsigned x;
    volatile LAS unsigned* st;
};

__device__ __forceinline__ XcdBarrier xcd_barrier_post(unsigned* bar, volatile LAS unsigned* st) {
    XcdBarrier b; b.bar = bar; b.x = xb_xcc_id(); b.st = st;
    if (threadIdx.x == 0) (void)xb_add(&bar[XB_XCNT(b.x)], 1u);
    return b;
}
__device__ __forceinline__ void xcd_barrier_complete(unsigned* bar, unsigned x, unsigned& nloc, unsigned& nx) {
    const unsigned G = gridDim.x * gridDim.y * gridDim.z;
    unsigned sum, cnt, mine, sp = 0u;
    for (;;) {
        sum = 0u; cnt = 0u; mine = 0u;
#pragma unroll
        for (unsigned j = 0; j < 16; ++j) { const unsigned c = xb_ld(&bar[XB_XCNT(j)]); sum += c; cnt += (c > 0u) ? 1u : 0u; mine = (j == x) ? c : mine; }
        if (sum == G) break;
        __builtin_amdgcn_s_sleep(1);
        if ((++sp & 255u) == 0u) { if (xb_ld(&bar[XB_TMO])) break; if (sp > XB_SPIN_CAP) { atomicAdd(&bar[XB_TMO], 1u); break; } }
    }
    nloc = mine > 0u ? mine : 1u; nx = cnt > 0u ? cnt : 1u;
}

__device__ __forceinline__ void xcd_barrier(const XcdBarrier& b) {
    asm volatile("s_waitcnt vmcnt(0)" ::: "memory");
    __syncthreads();
    if (threadIdx.x == 0) {
        unsigned* bar = b.bar;
        __builtin_amdgcn_s_waitcnt(0);
        unsigned nloc = b.st[0], nx = b.st[1];
        if (nloc == 0u) { xcd_barrier_complete(bar, b.x, nloc, nx); b.st[0] = nloc; b.st[1] = nx; }
        const unsigned old = xb_add(&bar[XB_XSUB(b.x)], 1u);
        const unsigned gen = old / nloc;
        if (old + 1u == (gen + 1u) * nloc) {
            __builtin_amdgcn_fence(__ATOMIC_RELEASE, "agent");
            asm volatile("s_waitcnt vmcnt(0)" ::: "memory");
            const unsigned og = xb_add(&bar[XB_TOP], 1u);
            const unsigned tg = og / nx;
            if (og + 1u == (tg + 1u) * nx) xb_add(&bar[XB_TOPGEN], 1u);
            else XB_SPIN(xb_ld(&bar[XB_TOPGEN]) == tg, bar);
            __builtin_amdgcn_fence(__ATOMIC_ACQUIRE, "agent");
            xb_add(&bar[XB_XGEN(b.x)], 1u);
            asm volatile("s_waitcnt vmcnt(0)" ::: "memory");
        } else {
            XB_SPIN(xb_ld(&bar[XB_XGEN(b.x)]) == gen, bar);
            __builtin_amdgcn_fence(__ATOMIC_ACQUIRE, "agent");
            asm volatile("s_waitcnt vmcnt(0)" ::: "memory");
        }
    }
    __syncthreads();
}


__device__ __forceinline__ void grid_barrier(cg::grid_group& grid, int wave) {
    asm volatile("s_waitcnt vmcnt(0) lgkmcnt(0)" ::: "memory");
    grid.sync();
    if (wave == 0) { __builtin_amdgcn_fence(__ATOMIC_ACQUIRE, "agent"); asm volatile("s_waitcnt vmcnt(0)" ::: "memory"); }
    __syncthreads();
}

struct Args { const float* in[18]; float* out; unsigned char* ws; int use_cg_sync; int pad; };

__global__ void __launch_bounds__(NTHREADS, 2) fwd_kernel(Args a) {
    extern __shared__ __attribute__((aligned(16))) unsigned char lds_raw[];
    LAS unsigned char* lds = (LAS unsigned char*)lds_raw;
    cg::grid_group grid = cg::this_grid();
    if (threadIdx.x < 16) ((LAS unsigned*)(lds + LDS_CTL))[threadIdx.x] = 0u;
    __syncthreads();
    const XcdBarrier xbar = xcd_barrier_post((unsigned*)(a.ws + WS_BAR), (volatile LAS unsigned*)(lds + LDS_CTL));
    const int tid = threadIdx.x, lane0 = tid & 63, wave = __builtin_amdgcn_readfirstlane(tid >> 6);
    const int G = gridDim.x, bid = blockIdx.x;
    const int gw = bid * NWAVES + wave, NGW = G * NWAVES;
    const int NGT = G * NTHREADS;

    const float* x_in = a.in[0]; const int* positions = (const int*)a.in[1];
    const float* ln1_g = a.in[2]; const float* w_in = a.in[3]; const float* qn_a = a.in[4]; const float* kn_a = a.in[5];
    const float* rpb = a.in[6]; const float* qn_b = a.in[7]; const float* kn_b = a.in[8]; const float* sink = a.in[9];
    const float* on_a = a.in[10]; const float* on_b = a.in[11]; const float* w_out = a.in[12]; const float* ln2_g = a.in[13];
    const float* w_up = a.in[14]; const float* conv_w = a.in[15]; const float* conv_b = a.in[16]; const float* w_down = a.in[17];
    float* xout = a.out;
    unsigned char* ws = a.ws;
    float* ssq1 = (float*)(ws + WS_SSQ); float* ssq2 = (float*)(ws + WS_SSQ2);
    bf16_t* WinT = (bf16_t*)(ws + WS_WIN); bf16_t* WoutT = (bf16_t*)(ws + WS_WOUT); bf16_t* WupT = (bf16_t*)(ws + WS_WUP); bf16_t* WdnT = (bf16_t*)(ws + WS_WDN);
    bf16_t* xb = (bf16_t*)(ws + WS_XB); bf16_t* proj = (bf16_t*)(ws + WS_PROJ); bf16_t* V2 = (bf16_t*)(ws + WS_VT); bf16_t* K2 = (bf16_t*)(ws + WS_K2); bf16_t* on = (bf16_t*)(ws + WS_ON);
    float* Ub = (float*)(ws + WS_U); bf16_t* act = (bf16_t*)(ws + WS_ACT);

    {
        LAS unsigned* scr = (LAS unsigned*)(lds + wave * 18432);
        constexpr int I_IN = (D / 64) * (PW / 128);
        for (int it = gw; it < I_IN; it += NGW) transpose_item(w_in, D, PW, ln1_g, ln1_g + 1024, WinT, scr, it, lane0, false, true);
        for (int i = bid * NTHREADS + tid; i < 192 * (D / 8); i += G * NTHREADS) { const int gr = i / (D / 8), c8 = i - gr * (D / 8); const long rowi = (gr == 0) ? -1 : (S + gr - 1);
            *(u32x4*)(xb + rowi * (long)D + c8 * 8) = (u32x4){0u, 0u, 0u, 0u}; }
        for (int row = gw; row < S; row += NGW) {
            const f32x4* xr = (const f32x4*)(x_in + (size_t)row * D) + lane0;
            u32x2* o8 = (u32x2*)(xb + (size_t)row * D) + lane0;
            float s = 0.f;
#pragma unroll
            for (int j = 0; j < 8; ++j) { const f32x4 v = xr[64 * j]; s += (v[0] * v[0] + v[1] * v[1]) + (v[2] * v[2] + v[3] * v[3]); u32x2 w; w.x = cvt_pk_bf16(v[0], v[1]); w.y = cvt_pk_bf16(v[2], v[3]); o8[64 * j] = w; }
            s = wave_sum(s, lane0);
            if (lane0 < 32) ssq1[(size_t)row * 32 + lane0] = (lane0 == 0) ? s : 0.f;
        }
    }
    if (a.use_cg_sync) grid_barrier(grid, wave); else xcd_barrier(xbar);

    int ltid = threadIdx.x;
#pragma unroll 1
    for (int ph = 0; ph < DEPTH * 5; ++ph) {
        const int layer = ph / 5, k = ph - 5 * layer;
        asm volatile("" : "+v"(ltid));
        if (k != 1) {
            pg8::Gemm g; pg8::Epi E;
            const bool m1 = (k == 2) || (k == 4);
            g.M = S; g.arow_step = (k == 3) ? 254 : 256; g.arow_off = (k == 3) ? -1 : 0;
            g.A = (k == 2) ? on : ((k == 4) ? act : xb);
            g.Bt = (k == 0) ? WinT + (size_t)layer * PW * D : (k == 2) ? WoutT + (size_t)layer * D * D : (k == 3) ? WupT + (size_t)layer * UW * D : WdnT + (size_t)layer * D * DFF;
            g.N = (k == 0) ? PW : (k == 3) ? UW : D;
            g.K = (k == 4) ? DFF : D;
            E.mode = m1 ? ((k == 4 && layer + 1 == DEPTH) ? 3 : 1) : ((k == 3) ? 2 : 0);
            E.O = (k == 0) ? proj : act; E.ldc = (k == 0) ? PW : DFF;
            E.cw = conv_w + (size_t)layer * 3 * UW; E.cbv = conv_b + (size_t)layer * UW; E.Ub = Ub;
            E.ssq = (k == 0) ? ssq1 : ssq2;
            E.xin = (k == 2 && layer == 0) ? x_in : xout; E.xout = xout; E.xb = xb;
            E.ssq_next = (k == 2) ? ssq2 : ssq1;
            E.K2 = K2; E.V2 = V2; E.positions = positions; E.nqa = qn_a + layer * 128; E.nka = kn_a + layer * 128; E.nqb = qn_b + layer * 128; E.nkb = kn_b + layer * 128;
            pg8::StaticOrder so; so.init((k == 3) ? 33 * 256 : S, g.N, G, bid);
            pg8::gemm_phase(lds, g, so, E, ltid);
            asm volatile("" : "+v"(ltid)); const int lane = ltid & 63;
            constexpr int I_IN = (D / 64) * (PW / 128), I_OUT = (D / 64) * (D / 128), I_UP = (D / 64) * (UW / 128), I_DN = (DFF / 64) * (D / 128);
            const int first = (G == 256) ? ((k == 0) ? 64 : 172) : 0;
            if ((k == 0 || k == 3) && bid >= first) {
                LAS unsigned* scr = (LAS unsigned*)(lds + wave * 18432);
                const int n_in = (layer + 1 < DEPTH) ? I_IN : 0;
                const int nit = (k == 0) ? (I_OUT + I_UP + n_in) : I_DN, nw = (G - first) * NWAVES;
                for (int it = (bid - first) * NWAVES + wave; it < nit; it += nw) {
                    const float* W; const float* g0; const float* g1; bf16_t* WT; int K_, N_, r = it;
                    if (k == 3) { W = w_down + (size_t)layer * DFF * D; K_ = DFF; N_ = D; g0 = nullptr; g1 = nullptr; WT = WdnT + (size_t)layer * D * DFF; }
                    else if (r < I_OUT) { W = w_out + (size_t)layer * D * D; K_ = D; N_ = D; g0 = on_a + layer * 1024; g1 = on_b + layer * 1024; WT = WoutT + (size_t)layer * D * D; }
                    else if (r < I_OUT + I_UP) { r -= I_OUT; W = w_up + (size_t)layer * D * UW; K_ = D; N_ = UW; g0 = ln2_g + layer * D; g1 = g0 + 1024; WT = WupT + (size_t)layer * UW * D; }
                    else { r -= I_OUT + I_UP; const int l = layer + 1; W = w_in + (size_t)l * D * PW; K_ = D; N_ = PW; g0 = ln1_g + l * D; g1 = g0 + 1024; WT = WinT + (size_t)l * PW * D; }
                    transpose_item(W, K_, N_, g0, g1, WT, scr, r, lane, N_ == UW, N_ == PW);
                }
            }
        }
        else if (k == 1) {
            const int lane = ltid & 63;
            LAS float* redbase = (LAS float*)lds;
            LAS float* rpl = (LAS float*)(lds + 4096 + wave * 4096 + 256);
            const int ql = lane & 31, hi = lane >> 5, w = wave;
            {
                const float* rp = rpb + ((size_t)layer * 8 + w) * (15 * 31);
                for (int i = lane; i < 15 * 31; i += 64) rpl[i] = rp[i] * LOG2E;
                asm volatile("s_waitcnt lgkmcnt(0)" ::: "memory");
            }
            int ucount = 0;
#pragma unroll 1
            for (int u0 = bid; u0 < 512; u0 += G, ++ucount) {
                const int u = (G == 256) ? ((u0 & ~255) + (u0 & 7) * 32 + ((u0 & 255) >> 3)) : u0;
                LAS float* red = redbase + (ucount & 1) * 256;
                if (u < 256) {
                    const int r = u >> 1, h = u & 1;
                    const int qc = 32 * h + ql, tq = r * 64 + qc;
                    const int lo = 2 * min(max(r - 4, 0), 120);
                    const size_t fo = ((size_t)(w * 256 + lo) * 8) * 512 + lane * 8;
                    attn_unit<true>(proj + (size_t)tq * PW + w * 128 + 8 * hi, K2 + fo, V2 + fo, lo, 16, tq, r, qc, rpl, -1e30f, 0.f, red, w, lane, on + (size_t)tq * D + w * 128);
                } else {
                    const int qb = u - 256, tq = qb * 32 + ql, kvh = w >> 2;
                    const int lo = max(qb - 4, 0), hb = min(qb + 4, 255);
                    const size_t fo = ((size_t)((8 + kvh) * 256 + lo) * 8) * 512 + lane * 8;
                    attn_unit<false>(proj + (size_t)tq * PW + 3072 + w * 128 + 8 * hi, K2 + fo, V2 + fo, lo, hb - lo + 1, tq, 0, 0, rpl, sink[layer * 8 + w] * LOG2E, (hi == 0) ? 1.0f : 0.0f, red, w, lane,
                                     on + (size_t)tq * D + 1024 + w * 128);
                }
            }
        }
        if (ph + 1 < DEPTH * 5) xcd_barrier(xbar);
    }
}

extern "C" void kernel_launch(void* const* d_in, const int* in_sizes, int n_in, void* d_out, int out_size, void* d_ws, size_t ws_size, hipStream_t stream) {
    static int grid = 0;
    if (grid == 0) {
        if (n_in != 18 || out_size != S * D || ws_size < WS_END) { fprintf(stderr, "kernel_launch: unexpected shapes (n_in %d out %d ws %zu)\n", n_in, out_size, ws_size); grid = -1; return; }
        int dev = 0, cus = 0, per_cu = 0;
        hipGetDevice(&dev);
        hipDeviceGetAttribute(&cus, hipDeviceAttributeMultiprocessorCount, dev);
        if (hipFuncSetAttribute((const void*)fwd_kernel, hipFuncAttributeMaxDynamicSharedMemorySize, LDS_BYTES) != hipSuccess) { fprintf(stderr, "kernel_launch: hipFuncSetAttribute failed\n"); grid = -1; return; }
        if (hipOccupancyMaxActiveBlocksPerMultiprocessor(&per_cu, (const void*)fwd_kernel, NTHREADS, LDS_BYTES) != hipSuccess || per_cu < 1) { fprintf(stderr, "kernel_launch: occupancy query failed (%d)\n", per_cu); per_cu = 1; }
        (void)hipGetLastError();
        grid = cus * 1;
        if (grid > 256) grid = 256;
    }
    if (grid < 0) return;
    if (hipMemsetAsync((char*)d_ws + WS_BAR, 0, 16384, stream) != hipSuccess) { fprintf(stderr, "kernel_launch: hipMemsetAsync failed\n"); return; }
    Args a{};
    for (int i = 0; i < 18; ++i) a.in[i] = (const float*)d_in[i];
    a.out = (float*)d_out; a.ws = (unsigned char*)d_ws;
    void* args[] = {&a};
    hipError_t e = hipLaunchCooperativeKernel((const void*)fwd_kernel, dim3(grid), dim3(NTHREADS), args, LDS_BYTES, stream);
    if (e != hipSuccess) fprintf(stderr, "cooperative launch failed: %s (grid %d)\n", hipGetErrorString(e), grid);
}
```

```cpp
#include <hip/hip_runtime.h>
#include <hip/hip_cooperative_groups.h>
#include <cstdio>
#include <cstdint>
namespace cg = cooperative_groups;

#define LAS __attribute__((address_space(3)))
typedef unsigned short bf16_t;
typedef short bf16x8 __attribute__((ext_vector_type(8)));
typedef float f32x4 __attribute__((ext_vector_type(4)));
typedef float f32x16 __attribute__((ext_vector_type(16)));
typedef unsigned u32x4 __attribute__((ext_vector_type(4)));
typedef unsigned u32x2 __attribute__((ext_vector_type(2)));

constexpr int S = 8192, D = 2048, DEPTH = 4, PW = 4608, DFF = 5632, UW = 2 * DFF;
constexpr float EPS = 1e-6f;
constexpr float LOG2E = 1.4426950408889634f;
constexpr float QSCALE = 0.08838834764831845f * LOG2E;
constexpr int NWAVES = 8, NTHREADS = 512;
#ifndef PG8_SP2
#define PG8_SP2 1
#endif
constexpr int LDS_BYTES = 149504 + 256;
constexpr int LDS_CTL = 149504;

constexpr size_t MiB = 1u << 20;
constexpr size_t WS_SSQ = 0;
constexpr size_t WS_WIN = 1 * MiB;
constexpr size_t WS_WOUT = WS_WIN + 72 * MiB;
constexpr size_t WS_WUP = WS_WOUT + 32 * MiB;
constexpr size_t WS_WDN = WS_WUP + 176 * MiB;
constexpr size_t WS_XB = WS_WDN + 89 * MiB;
constexpr size_t WS_PROJ = WS_XB + 33 * MiB;
constexpr size_t WS_VT = WS_PROJ + 72 * MiB;
constexpr size_t WS_ON = WS_VT + 20 * MiB;
constexpr size_t WS_U = WS_ON + 32 * MiB;
constexpr size_t WS_ACT = WS_U + 176 * MiB;
constexpr size_t WS_SSQ2 = WS_ACT + 89 * MiB;
constexpr size_t WS_BAR = WS_SSQ2 + 1 * MiB;
constexpr size_t WS_K2 = WS_BAR + 1 * MiB;
constexpr size_t WS_END = WS_K2 + 20 * MiB;

__device__ __forceinline__ unsigned cvt_pk_bf16(float lo, float hi) { unsigned r; asm volatile("v_cvt_pk_bf16_f32 %0, %1, %2" : "=v"(r) : "v"(lo), "v"(hi)); return r; }
__device__ __forceinline__ float bf2f(bf16_t u) { return __uint_as_float((unsigned)u << 16); }
__device__ __forceinline__ float bflo(unsigned u) { return __uint_as_float(u << 16); }
__device__ __forceinline__ float bfhi(unsigned u) { return __uint_as_float(u & 0xffff0000u); }
__device__ __forceinline__ float shfl_xor_l(float v, int mask, int lane) { return __builtin_bit_cast(float, __builtin_amdgcn_ds_bpermute((lane ^ mask) << 2, __builtin_bit_cast(int, v))); }
__device__ __forceinline__ float wave_sum(float v, int lane) {
#pragma unroll
    for (int o = 1; o < 64; o <<= 1) v += shfl_xor_l(v, o, lane);
    return v;
}

namespace pg8 {
constexpr int BM = 256, BK = 64, HALF = 128, HTB = HALF * BK * 2, NXCD = 8, WGM = 8;
__device__ __forceinline__ int lds_byte(int r, int c) { const int st = (r >> 4) * 2 + (c >> 5), rr = r & 15, cc = c & 31, ob = rr * 64 + cc * 2; return st * 1024 + (ob ^ (((ob >> 9) & 1) << 5)); }
__device__ __forceinline__ void stage_rc(int b, int& R, int& C) { const int st = b / 1024, sb = b % 1024, swz = sb ^ (((sb >> 9) & 1) << 5); R = (st >> 1) * 16 + swz / 64; C = (st & 1) * 32 + (swz % 64) / 2; }
__device__ __forceinline__ int perm32(int rho) { const int n = rho >> 4, i = rho & 15; return 8 * (i >> 2) + 4 * n + (i & 3); }

struct Unit { int pm, pn; };
struct Gemm { const bf16_t* A; const bf16_t* Bt; int M, N, K; int arow_step, arow_off; };

struct StaticOrder {
    int nM, nN, nwg, G, c;
    __device__ void init(int M, int N, int G_, int c_) { nM = M / BM; nN = N / BM; nwg = nM * nN; G = G_; c = c_; }
    __device__ bool next(int i, Unit& u) const {
        const long L = (long)i * G + c; if (L >= nwg) return false;
        int wgid = (int)L; { const int q = nwg / NXCD, r = nwg % NXCD, xcd = wgid % NXCD, off = wgid / NXCD; wgid = (xcd < r ? xcd * (q + 1) : r * (q + 1) + (xcd - r) * q) + off; }
        const int nig = WGM * nN, gid = wgid / nig, fm = gid * WGM, gsz = (nM - fm) < WGM ? (nM - fm) : WGM;
        u.pm = fm + ((wgid % nig) % gsz); u.pn = (wgid % nig) / gsz; return true;
    }
};

template <bool ROPE>
__device__ __forceinline__ void qk_epi(const f32x4 (&acc)[2][2][4][2], int pm, int pn, int wr, int wc, int fr, int fq, const LAS float* rstab, LAS float* P,
                                       const float* nw, bool isq, bool isk, int kh0, bf16_t* proj, bf16_t* K2, const int* positions) {
    const int ln = (fq << 4) | fr;
#pragma unroll
    for (int ai = 0; ai < 2; ++ai)
#pragma unroll
        for (int m = 0; m < 4; ++m) {
            const int rl = ai * HALF + wr * 64 + m * 16 + fr;
            const float rs = rstab[rl];
#pragma unroll
            for (int bj = 0; bj < 2; ++bj) {
                const f32x4 a0 = acc[ai][bj][m][0] * rs, a1 = acc[ai][bj][m][1] * rs;
                float sq = ((a0[0] * a0[0] + a0[1] * a0[1]) + (a0[2] * a0[2] + a0[3] * a0[3])) + ((a1[0] * a1[0] + a1[1] * a1[1]) + (a1[2] * a1[2] + a1[3] * a1[3]));
                sq += shfl_xor_l(sq, 16, ln); sq += shfl_xor_l(sq, 32, ln);
                P[(rl * 2 + bj) * 4 + wc] = sq;
            }
        }
    asm volatile("s_waitcnt lgkmcnt(0)" ::: "memory"); __builtin_amdgcn_s_barrier(); asm volatile("" ::: "memory");
    const int blk = 4 * wc + fq, p0 = 8 * blk;
    f32x4 wv[2]; float invf[4];
#pragma unroll
    for (int n = 0; n < 2; ++n) wv[n] = ROPE ? *(const f32x4*)(nw + 64 * n + 4 * blk) : *(const f32x4*)(nw + p0 + 4 * n);
#pragma unroll
    for (int j = 0; j < 4; ++j) invf[j] = __builtin_amdgcn_exp2f(-(float)(4 * blk + j) * (2.0f / 128.0f) * 13.287712379549449f);
    const float qs = isq ? QSCALE : 1.0f;
#pragma unroll
    for (int ai = 0; ai < 2; ++ai)
#pragma unroll
        for (int m = 0; m < 4; ++m) {
            asm volatile("" ::: "memory");
            const int rl = ai * HALF + wr * 64 + m * 16 + fr, row = pm * BM + rl;
            const float rs = rstab[rl] * qs;
            f32x4 cs, sn;
            if (ROPE) {
                const float pos = (float)positions[row];
#pragma unroll
                for (int j = 0; j < 4; ++j) { const float ang = pos * invf[j]; double rev = (double)ang * 0.15915494309189535; rev -= __builtin_rint(rev); const float rf = (float)rev;
                    cs[j] = __builtin_amdgcn_cosf(rf); sn[j] = __builtin_amdgcn_sinf(rf); }
            }
            const int kblk = 8 * pm + 4 * ai + 2 * wr + (m >> 1), tl = 16 * (m & 1) + fr;
#pragma unroll
            for (int bj = 0; bj < 2; ++bj) {
                const f32x4 part = *(const LAS f32x4*)(P + (rl * 2 + bj) * 4);
                const float hr = __builtin_amdgcn_rsqf(((part[0] + part[1]) + (part[2] + part[3])) * (1.0f / 128.0f) + EPS) * rs;
                f32x4 y0 = acc[ai][bj][m][0] * hr * wv[0], y1 = acc[ai][bj][m][1] * hr * wv[1];
                if (ROPE) { const f32x4 o0 = y0 * cs - y1 * sn, o1 = y1 * cs + y0 * sn; y0 = o0; y1 = o1; }
                u32x4 w; w.x = cvt_pk_bf16(y0[0], y0[1]); w.y = cvt_pk_bf16(y0[2], y0[3]); w.z = cvt_pk_bf16(y1[0], y1[1]); w.w = cvt_pk_bf16(y1[2], y1[3]);
                bf16_t* qa_ = proj + (size_t)row * PW + pn * BM + bj * HALF + p0;
                bf16_t* ka_ = K2 + ((size_t)(((kh0 + bj) * 256 + kblk) * 8 + (blk >> 1)) * 64 + (blk & 1) * 32 + tl) * 8;
                *(u32x4*)(isk ? ka_ : qa_) = w;
            }
        }
}
__device__ __forceinline__ void v_epi(const f32x4 (&acc)[2][2][4][2], int pm, int wr, int wc, int fr, int fq, const LAS float* rstab, int vh0, bf16_t* V2, LAS bf16_t* T) {
    const int ln = (fq << 4) | fr, dl = ln & 31, hi2 = ln >> 5;
    LAS bf16_t* wp = T + fr * 40 + 8 * fq;
    const LAS bf16_t* rp = T + (4 * hi2) * 40 + dl;
#pragma unroll
    for (int ai = 0; ai < 2; ++ai)
#pragma unroll
        for (int m = 0; m < 4; ++m) {
            const int rl = ai * HALF + wr * 64 + m * 16 + fr;
            const float rs = rstab[rl];
            const int kblk = 8 * pm + 4 * ai + 2 * wr + (m >> 1);
#pragma unroll
            for (int bj = 0; bj < 2; ++bj) {
                const f32x4 v0 = acc[ai][bj][m][0] * rs, v1 = acc[ai][bj][m][1] * rs;
                u32x4 w; w.x = cvt_pk_bf16(v0[0], v0[1]); w.y = cvt_pk_bf16(v0[2], v0[3]); w.z = cvt_pk_bf16(v1[0], v1[1]); w.w = cvt_pk_bf16(v1[2], v1[3]);
                *(LAS u32x4*)wp = w;
                asm volatile("s_waitcnt lgkmcnt(0)" ::: "memory");
                u32x4 o;
                o.x = (unsigned)rp[0 * 40] | ((unsigned)rp[1 * 40] << 16); o.y = (unsigned)rp[2 * 40] | ((unsigned)rp[3 * 40] << 16);
                o.z = (unsigned)rp[8 * 40] | ((unsigned)rp[9 * 40] << 16); o.w = (unsigned)rp[10 * 40] | ((unsigned)rp[11 * 40] << 16);
                asm volatile("s_waitcnt lgkmcnt(0)" ::: "memory");
                *(u32x4*)(V2 + ((size_t)((((vh0 + bj) * 256 + kblk) * 4 + wc) * 2 + (m & 1)) * 64 + ln) * 8) = o;
            }
        }
}

template <bool F32OUT>
__device__ __forceinline__ void res_epi(const f32x4 (&acc)[2][2][4][2], int pm, int pn, int wr, int wc, int fr, int fq, bf16_t* xb, float* xout, float* ssq_next) {
    const int row0 = pm * BM + wr * 64 + fr, col0 = pn * BM + wc * 32 + 8 * fq, ln = (fq << 4) | fr;
#pragma unroll
    for (int ai = 0; ai < 2; ++ai) {
#pragma unroll
        for (int m = 0; m < 4; ++m) {
            const int row = row0 + ai * HALF + m * 16;
            const size_t off = (size_t)row * D + col0;
            u32x4 r[2];
#pragma unroll
            for (int bj = 0; bj < 2; ++bj) r[bj] = *(const u32x4*)(xb + off + bj * HALF);
            float s = 0.f;
#pragma unroll
            for (int bj = 0; bj < 2; ++bj) {
                f32x4 v0 = acc[ai][bj][m][0], v1 = acc[ai][bj][m][1];
                v0[0] += bflo(r[bj].x); v0[1] += bfhi(r[bj].x); v0[2] += bflo(r[bj].y); v0[3] += bfhi(r[bj].y);
                v1[0] += bflo(r[bj].z); v1[1] += bfhi(r[bj].z); v1[2] += bflo(r[bj].w); v1[3] += bfhi(r[bj].w);
                if (F32OUT) { *(f32x4*)(xout + off + bj * HALF) = v0; *(f32x4*)(xout + off + bj * HALF + 4) = v1; }
                s += ((v0[0] * v0[0] + v0[1] * v0[1]) + (v0[2] * v0[2] + v0[3] * v0[3])) + ((v1[0] * v1[0] + v1[1] * v1[1]) + (v1[2] * v1[2] + v1[3] * v1[3]));
                u32x4 w; w.x = cvt_pk_bf16(v0[0], v0[1]); w.y = cvt_pk_bf16(v0[2], v0[3]); w.z = cvt_pk_bf16(v1[0], v1[1]); w.w = cvt_pk_bf16(v1[2], v1[3]);
                if (!F32OUT) *(u32x4*)(xb + off + bj * HALF) = w;
            }
            if (!F32OUT) { s += shfl_xor_l(s, 16, ln); s += shfl_xor_l(s, 32, ln);
                ssq_next[(size_t)row * 32 + pn * 4 + wc] = s; }
            if (m & 1) asm volatile("" ::: "memory");
        }
    }
}

struct Epi {
    int mode;
    bf16_t* O; int ldc; const float* ssq;
    const float* xin; float* xout; bf16_t* xb; float* ssq_next;
    bf16_t* K2; bf16_t* V2; const int* positions; const float* nqa; const float* nka; const float* nqb; const float* nkb;
    const float* cw; const float* cbv; float* Ub;
    __device__ __forceinline__ void operator()(const f32x4 (&acc)[2][2][4][2], const Unit& u, int wr, int wc, int fr, int fq, const LAS float* rstab, LAS float* X, const LAS float* wtab) const {
        const int row0 = u.pm * BM + wr * 64 + fr;
        if (mode == 2) {
            const int cl0 = wc * 32 + 8 * fq;
#pragma unroll
            for (int ai = 0; ai < 2; ++ai) {
                const int q = 2 * ai + wr;
                float rs0 = rstab[wr * 64 + fr + ai * HALF], rs3 = rstab[wr * 64 + fr + ai * HALF + 48];
                asm volatile("" : "+v"(rs0), "+v"(rs3));
                if (fr == 0) {
#pragma unroll
                    for (int bj = 0; bj < 2; ++bj)
#pragma unroll
                        for (int n = 0; n < 2; ++n) *(LAS f32x4*)(X + ((q * 2 + 0) * 2 + bj) * 128 + cl0 + 4 * n) = acc[ai][bj][0][n] * rs0;
                }
                if (fr == 15) {
#pragma unroll
                    for (int bj = 0; bj < 2; ++bj)
#pragma unroll
                        for (int n = 0; n < 2; ++n) *(LAS f32x4*)(X + ((q * 2 + 1) * 2 + bj) * 128 + cl0 + 4 * n) = acc[ai][bj][3][n] * rs3;
                }
            }
            asm volatile("s_waitcnt lgkmcnt(0)" ::: "memory"); __builtin_amdgcn_s_barrier(); asm volatile("" ::: "memory");
            const int chg = u.pn * HALF + cl0;
#pragma unroll
            for (int ai = 0; ai < 2; ++ai) {
                asm volatile("" ::: "memory");
                const int q = 2 * ai + wr;
                float rs[4];
#pragma unroll
                for (int m = 0; m < 4; ++m) rs[m] = rstab[wr * 64 + fr + ai * HALF + m * 16];
                u32x2 lo[4];
#pragma unroll
                for (int n = 0; n < 2; ++n) {
                    float G[4][4];
#pragma unroll
                    for (int bj = 0; bj < 2; ++bj) {
                        asm volatile("" ::: "memory");
                        f32x4 wt[4];
                        { const LAS float* wp_ = wtab + bj * HALF + cl0 + 4 * n; wt[0] = *(const LAS f32x4*)wp_; wt[1] = *(const LAS f32x4*)(wp_ + 256); wt[2] = *(const LAS f32x4*)(wp_ + 512); wt[3] = *(const LAS f32x4*)(wp_ + 768); }
                        const f32x4 Bp = *(const LAS f32x4*)(X + (((q > 0 ? q - 1 : 0) * 2 + 1) * 2 + bj) * 128 + cl0 + 4 * n);
                        const f32x4 Bn = *(const LAS f32x4*)(X + (((q < 3 ? q + 1 : 3) * 2 + 0) * 2 + bj) * 128 + cl0 + 4 * n);
#pragma unroll
                        for (int j = 0; j < 4; ++j) {
                            __builtin_amdgcn_sched_barrier(0);
                            float V[4], P[4], N[4];
#pragma unroll
                            for (int m = 0; m < 4; ++m) { V[m] = acc[ai][bj][m][n][j] * rs[m];
                                P[m] = __builtin_bit_cast(float, __builtin_amdgcn_mov_dpp(__builtin_bit_cast(int, V[m]), 0x121, 0xf, 0xf, true));
                                N[m] = __builtin_bit_cast(float, __builtin_amdgcn_mov_dpp(__builtin_bit_cast(int, V[m]), 0x12F, 0xf, 0xf, true)); }
#pragma unroll
                            for (int m = 0; m < 4; ++m) {
                                const float pv = (fr > 0) ? P[m] : ((m > 0) ? P[m > 0 ? m - 1 : 0] : Bp[j]);
                                const float nv = (fr < 15) ? N[m] : ((m < 3) ? N[m < 3 ? m + 1 : 3] : Bn[j]);
                                const float cvv = wt[0][j] * pv + wt[1][j] * V[m] + wt[2][j] * nv + wt[3][j];
                                if (bj == 0) G[m][j] = cvv;
                                else { const float g = G[m][j]; G[m][j] = g * __builtin_amdgcn_rcpf(1.0f + __builtin_amdgcn_exp2f(-g * LOG2E)) * cvv; }
                            }
                        }
                    }
#pragma unroll
                    for (int m = 0; m < 4; ++m) {
                        const int rl = ai * HALF + wr * 64 + m * 16 + fr;
                        u32x2 ov; ov.x = cvt_pk_bf16(G[m][0], G[m][1]); ov.y = cvt_pk_bf16(G[m][2], G[m][3]);
                        if (n == 0) lo[m] = ov;
                        else { u32x4 o4; o4.x = lo[m].x; o4.y = lo[m].y; o4.z = ov.x; o4.w = ov.y;
                            const int grow = u.pm * 254 - 1 + rl; const int rsel = ((rl >= 1) && (rl <= 254) && (grow < S)) ? grow : S;
                            bf16_t* dst = O + (size_t)rsel * ldc + chg;
                            *(u32x4*)dst = o4; }
                    }
                }
            }
        } else if (mode == 0) {
            const int pn = u.pn;
            if ((pn >= 8 && pn < 12) || pn == 17) v_epi(acc, u.pm, wr, wc, fr, fq, rstab, (pn == 17) ? 8 : 2 * (pn - 8), V2, (LAS bf16_t*)X + (wr * 4 + wc) * 640);
            else if (pn >= 12) qk_epi<true>(acc, u.pm, pn, wr, wc, fr, fq, rstab, X, (pn == 16) ? nkb : nqb, pn != 16, pn == 16, 8, O, K2, positions);
            else qk_epi<false>(acc, u.pm, pn, wr, wc, fr, fq, rstab, X, (pn < 4) ? nqa : nka, pn < 4, pn >= 4, 2 * (pn - 4), O, K2, positions);
        } else if (mode == 3) {
            res_epi<true>(acc, u.pm, u.pn, wr, wc, fr, fq, xb, xout, ssq_next);
        } else {
            res_epi<false>(acc, u.pm, u.pn, wr, wc, fr, fq, xb, xout, ssq_next);
        }
    }
};

__device__ __forceinline__ void gemm_phase(LAS unsigned char* lds, const Gemm g, const StaticOrder& S_, const Epi& E, const int tid) {
    const int wid = __builtin_amdgcn_readfirstlane(tid >> 6), lane = tid & 63, wr = wid >> 2, wc = wid & 3, fr = lane & 15, fq = lane >> 4;
    const int K = g.K, nt = K / BK;
    unsigned voffA[2], voffB[2];
#pragma unroll
    for (int i = 0; i < 2; ++i) { int R, C; stage_rc(tid * 16 + i * 8192, R, C); const int Rb = (R & ~31) + perm32(R & 31);
        voffA[i] = (unsigned)(R * K + C) * 2u; voffB[i] = (unsigned)(tid * 16 + i * 8192); (void)Rb; }
    const size_t kstep = (size_t)(BK * 2);
    const size_t hstep = (size_t)HALF * K * 2;
    const size_t tstep = 2 * hstep;
    const unsigned ldsw = (unsigned)wid * 1024u;
    const int aoff = lds_byte(wr * 64 + fr, fq * 8), boff = lds_byte(wc * 32 + fr, fq * 8);
#define PG8_SA(b, h) (((b) * 2 + (h)) * HTB)
#define PG8_SB(b, h) ((4 + (b) * 2 + (h)) * HTB)
#define PG8_STAGE(bufoff, gbase, voff) do { _Pragma("unroll") for (int _i = 0; _i < 2; ++_i) \
        __builtin_amdgcn_global_load_lds((const unsigned*)((const char*)(gbase) + (voff)[_i]), (LAS unsigned*)(lds + (bufoff) + ldsw + _i * 8192), 16, 0, 0); } while (0)
#define PG8_LDA(dst, b, h) do { _Pragma("unroll") for (int m = 0; m < 4; ++m) _Pragma("unroll") for (int k = 0; k < 2; ++k) dst[m][k] = *(const LAS bf16x8*)(lds + PG8_SA(b, h) + aoff + m * 2048 + k * 1024); } while (0)
#define PG8_LDB(dst, b, h) do { _Pragma("unroll") for (int n = 0; n < 2; ++n) _Pragma("unroll") for (int k = 0; k < 2; ++k) dst[n][k] = *(const LAS bf16x8*)(lds + PG8_SB(b, h) + boff + n * 2048 + k * 1024); } while (0)
#define PG8_MMA(ai, bj, At, Bt) do { __builtin_amdgcn_s_setprio(1); _Pragma("unroll") for (int m = 0; m < 4; ++m) _Pragma("unroll") for (int n = 0; n < 2; ++n) _Pragma("unroll") for (int k = 0; k < 2; ++k) \
        acc[ai][bj][m][n] = __builtin_amdgcn_mfma_f32_16x16x32_bf16(Bt[n][k], At[m][k], acc[ai][bj][m][n], 0, 0, 0); __builtin_amdgcn_s_setprio(0); } while (0)
#define PG8_WAIT_V(n) asm volatile("s_waitcnt vmcnt(" #n ")" ::: "memory")
#define PG8_WAIT_L(n) asm volatile("s_waitcnt lgkmcnt(" #n ")" ::: "memory")
#define PG8_BAR __builtin_amdgcn_s_barrier()
#define PG8_SCHED __builtin_amdgcn_sched_barrier(0)
    Unit cur, nxt; int ui = 0;
    if (!S_.next(0, cur)) return;
    f32x4 acc[2][2][4][2];
#pragma unroll
    for (int a = 0; a < 2; ++a)
#pragma unroll
        for (int b = 0; b < 2; ++b)
#pragma unroll
            for (int m = 0; m < 4; ++m)
#pragma unroll
                for (int n = 0; n < 2; ++n) acc[a][b][m][n] = (f32x4){0.f, 0.f, 0.f, 0.f};
    bf16x8 At[4][2], B0[2][2], B1[2][2];
    const long astep = (long)g.arow_step * K * 2, aoff0 = (long)g.arow_off * K * 2;
    const char* cA = (const char*)g.A + (long)cur.pm * astep + aoff0; const size_t kstepB = 32768, hstepB = 16384, tstepB = (size_t)nt * 32768;
    const char* cB = (const char*)g.Bt + (size_t)cur.pn * tstepB;
    LAS float* rstab = (LAS float*)(lds + 8 * HTB);
#define PG8_RSTAB(unit, par) do { int tr_ = tid; asm volatile("" : "+v"(tr_)); if ((E.mode == 0 || E.mode == 2) && tr_ < 256) { const int gr_ = (unit).pm * g.arow_step + g.arow_off + tr_; const bool ok_ = gr_ >= 0 && gr_ < g.M; const f32x4* sp_ = (const f32x4*)(E.ssq + (size_t)(ok_ ? gr_ : 0) * 32); f32x4 t4_ = sp_[0]; \
        _Pragma("unroll") for (int q_ = 1; q_ < 8; ++q_) t4_ = t4_ + sp_[q_]; \
        rstab[(par) * 256 + tr_] = ok_ ? __builtin_amdgcn_rsqf(((t4_[0] + t4_[1]) + (t4_[2] + t4_[3])) * (1.0f / D) + EPS) : 0.f;     \
        if (E.mode == 2) { const int c_ = (unit).pn * HALF + (tr_ & 127) + (tr_ >> 7) * DFF; LAS float* wt_ = rstab + 2560 + (par) * 1024 + tr_;     \
            wt_[0] = E.cw[c_]; wt_[256] = E.cw[UW + c_]; wt_[512] = E.cw[2 * UW + c_]; wt_[768] = E.cbv[c_]; } } } while (0)
#if PG8_SP2
    PG8_STAGE(PG8_SB(0, 0), cB, voffB); PG8_STAGE(PG8_SB(0, 1), cB + hstepB, voffB); PG8_STAGE(PG8_SA(0, 0), cA, voffA); PG8_STAGE(PG8_SA(0, 1), cA + hstep, voffA);
    PG8_RSTAB(cur, 0);
    if (wr == 1) PG8_BAR;
    PG8_WAIT_V(2); PG8_BAR;
    PG8_STAGE(PG8_SB(1, 0), cB + kstepB, voffB); PG8_STAGE(PG8_SA(1, 0), cA + kstep, voffA); PG8_STAGE(PG8_SB(1, 1), cB + hstepB + kstepB, voffB);
    PG8_WAIT_V(6); PG8_BAR;
#else
    PG8_STAGE(PG8_SB(0, 0), cB, voffB); PG8_STAGE(PG8_SA(0, 0), cA, voffA); PG8_STAGE(PG8_SB(0, 1), cB + hstepB, voffB); PG8_STAGE(PG8_SA(0, 1), cA + hstep, voffA);
    if (wr == 1) PG8_BAR;
    PG8_WAIT_V(4); PG8_BAR;
    PG8_STAGE(PG8_SB(1, 0), cB + kstepB, voffB); PG8_STAGE(PG8_SA(1, 0), cA + kstep, voffA); PG8_STAGE(PG8_SB(1, 1), cB + hstepB + kstepB, voffB);
    PG8_WAIT_V(6); PG8_BAR;
#endif
    for (;;) {
        const bool has_next = S_.next(ui + 1, nxt);
        const char* nA = has_next ? (const char*)g.A + (long)nxt.pm * astep + aoff0 : cA; const char* nB = has_next ? (const char*)g.Bt + (size_t)nxt.pn * tstepB : cB;
        for (int t = 0; t < nt; t += 2) {
            const bool last = (t == nt - 2);
            const char* a1 = cA + (size_t)(t + 1) * kstep;
            const char* a2 = last ? nA : cA + (size_t)(t + 2) * kstep; const char* b2 = last ? nB : cB + (size_t)(t + 2) * kstepB;
            const char* a3 = a2 + kstep; const char* b3 = b2 + kstepB;
#if PG8_SP2
            PG8_LDB(B0, 0, 0); PG8_LDB(B1, 0, 1); PG8_SCHED; PG8_LDA(At, 0, 0); PG8_STAGE(PG8_SA(1, 1), a1 + hstep, voffA);
            PG8_WAIT_V(8); PG8_WAIT_L(0); PG8_BAR; PG8_MMA(0, 0, At, B0); PG8_MMA(0, 1, At, B1); PG8_BAR; PG8_SCHED;
            PG8_LDA(At, 0, 1); PG8_STAGE(PG8_SB(0, 0), b2, voffB); PG8_STAGE(PG8_SB(0, 1), b2 + hstepB, voffB); PG8_STAGE(PG8_SA(0, 0), a2, voffA);
            PG8_WAIT_V(8); PG8_WAIT_L(0); PG8_BAR; PG8_MMA(1, 0, At, B0); PG8_MMA(1, 1, At, B1); PG8_BAR; PG8_SCHED;
            PG8_LDB(B0, 1, 0); PG8_LDB(B1, 1, 1); PG8_SCHED; PG8_LDA(At, 1, 0); PG8_STAGE(PG8_SA(0, 1), a2 + hstep, voffA);
            PG8_WAIT_V(8); PG8_WAIT_L(0); PG8_BAR; PG8_MMA(0, 0, At, B0); PG8_MMA(0, 1, At, B1); PG8_BAR; PG8_SCHED;
            PG8_LDA(At, 1, 1); PG8_STAGE(PG8_SB(1, 0), b3, voffB); PG8_STAGE(PG8_SB(1, 1), b3 + hstepB, voffB); PG8_STAGE(PG8_SA(1, 0), a3, voffA);
            PG8_WAIT_V(8); PG8_WAIT_L(0); PG8_BAR; PG8_MMA(1, 0, At, B0); PG8_MMA(1, 1, At, B1); PG8_BAR; PG8_SCHED;
        #else
            PG8_LDB(B0, 0, 0); PG8_SCHED; PG8_LDA(At, 0, 0); PG8_STAGE(PG8_SA(1, 1), a1 + hstep, voffA);
            PG8_WAIT_L(8); PG8_BAR; PG8_WAIT_L(0); PG8_MMA(0, 0, At, B0); PG8_BAR; PG8_SCHED;
            PG8_LDB(B1, 0, 1); PG8_STAGE(PG8_SB(0, 0), b2, voffB);
            PG8_BAR; PG8_WAIT_L(0); PG8_MMA(0, 1, At, B1); PG8_BAR;
            PG8_LDA(At, 0, 1); PG8_STAGE(PG8_SA(0, 0), a2, voffA);
            PG8_BAR; PG8_WAIT_L(0); PG8_MMA(1, 0, At, B0); PG8_BAR; PG8_SCHED;
            PG8_STAGE(PG8_SB(0, 1), b2 + hstepB, voffB);
            PG8_WAIT_V(6); PG8_BAR; PG8_MMA(1, 1, At, B1); PG8_BAR;
            PG8_LDB(B0, 1, 0); PG8_SCHED; PG8_LDA(At, 1, 0); PG8_STAGE(PG8_SA(0, 1), a2 + hstep, voffA);
            PG8_WAIT_L(8); PG8_BAR; PG8_WAIT_L(0); PG8_MMA(0, 0, At, B0); PG8_BAR; PG8_SCHED;
            PG8_LDB(B1, 1, 1); PG8_STAGE(PG8_SB(1, 0), b3, voffB);
            PG8_BAR; PG8_WAIT_L(0); PG8_MMA(0, 1, At, B1); PG8_BAR;
            PG8_LDA(At, 1, 1); PG8_STAGE(PG8_SA(1, 0), a3, voffA);
            PG8_BAR; PG8_WAIT_L(0); PG8_MMA(1, 0, At, B0); PG8_BAR; PG8_SCHED;
            PG8_STAGE(PG8_SB(1, 1), b3 + hstepB, voffB);
            PG8_WAIT_V(6); PG8_BAR; PG8_MMA(1, 1, At, B1); PG8_BAR;
#endif
}
        if (wr == 0) PG8_BAR;
        { int t_e = tid; asm volatile("" : "+v"(t_e)); const int fr_e = t_e & 15, fq_e = (t_e >> 4) & 3;
          E(acc, cur, wr, wc, fr_e, fq_e, rstab + (ui & 1) * 256, rstab + 512, rstab + 2560 + (ui & 1) * 1024); }
        if (!has_next) break;
#pragma unroll
        for (int a = 0; a < 2; ++a)
#pragma unroll
            for (int b = 0; b < 2; ++b)
#pragma unroll
                for (int m = 0; m < 4; ++m)
#pragma unroll
                    for (int n = 0; n < 2; ++n) acc[a][b][m][n] = (f32x4){0.f, 0.f, 0.f, 0.f};
        cur = nxt; cA = nA; cB = nB; ++ui;
        PG8_RSTAB(cur, ui & 1);
        if (wr == 1) PG8_BAR;
    }
    PG8_WAIT_V(0);
    PG8_BAR;
#undef PG8_SA
#undef PG8_SB
#undef PG8_STAGE
#undef PG8_LDA
#undef PG8_LDB
#undef PG8_MMA
#undef PG8_WAIT_V
#undef PG8_WAIT_L
#undef PG8_BAR
#undef PG8_SCHED
#undef PG8_RSTAB
}
}

__device__ __forceinline__ void transpose_item(const float* W, int K, int N, const float* g0, const float* g1, bf16_t* WT, LAS unsigned* T, int item, int lane, bool gate_up_interleave = false, bool rope_heads = false) {
    constexpr int PD = 36;
    const int nblk = N / 128, kb = item / nblk, nb = item % nblk, k0 = 64 * kb, n0 = 128 * nb;
    const float* gp = g0 ? (k0 < 1024 ? g0 + k0 : g1 + (k0 - 1024)) : nullptr;
    const int dn0 = gate_up_interleave ? ((nb < DFF / 128) ? 256 * nb : 256 * (nb - DFF / 128) + 128) : n0;
    const int l31 = lane & 31, kh = (lane >> 5) * 2;
    const float* wp = W + (size_t)(k0 + kh) * N + n0 + 4 * l31;
#pragma unroll 4
    for (int i = 0; i < 16; ++i) {
        const int kk = 4 * i + kh;
        f32x4 va = __builtin_nontemporal_load((const f32x4*)(wp + (size_t)(4 * i) * N)), vb = __builtin_nontemporal_load((const f32x4*)(wp + (size_t)(4 * i + 1) * N));
        if (gp) { va = va * gp[kk]; vb = vb * gp[kk + 1]; }
#pragma unroll
        for (int e = 0; e < 4; ++e) T[(4 * l31 + e) * PD + (kk >> 1)] = cvt_pk_bf16(va[e], vb[e]);
    }
    asm volatile("s_waitcnt lgkmcnt(0)" ::: "memory");
    const int c = lane & 7;
#pragma unroll 4
    for (int it = 0; it < 16; ++it) {
        const int n = 8 * it + (lane >> 3);
        const u32x4 o = *(const LAS u32x4*)(T + n * PD + 4 * c);
        const int nd = (rope_heads && nb >= 24 && nb < 34) ? ((n < 64) ? (8 * (n >> 2) + (n & 3)) : (8 * ((n - 64) >> 2) + 4 + (n & 3))) : n;
        const int nf = dn0 + nd, rw = nf & 127, x5 = rw & 31, slot = (rw & ~31) + 16 * ((x5 >> 2) & 1) + 4 * (x5 >> 3) + (x5 & 3);
        *(u32x4*)((char*)WT + ((size_t)((nf >> 8) * (K / 64) + (k0 >> 6)) * 2 + ((nf >> 7) & 1)) * 16384 + pg8::lds_byte(slot, 8 * c)) = o;
    }
    asm volatile("s_waitcnt lgkmcnt(0)" ::: "memory");
}

__device__ __forceinline__ void attn_finish(f32x16 (&o)[4], float l, LAS float* red, int w, int lane, bf16_t* outp  ) {
    const int ql = lane & 31, hi = lane >> 5;
    const float lt = l + shfl_xor_l(l, 32, lane);
    const float inv = 1.0f / lt;
    float ss = 0.f;
#pragma unroll
    for (int db = 0; db < 4; ++db)
#pragma unroll
        for (int i = 0; i < 16; ++i) { o[db][i] *= inv; ss += o[db][i] * o[db][i]; }
    ss += shfl_xor_l(ss, 32, lane);
    if (hi == 0) red[w * 32 + ql] = ss;
    __syncthreads();
    float tot = 0.f;
#pragma unroll
    for (int w2 = 0; w2 < 8; ++w2) tot += red[w2 * 32 + ql];
    const float rstd = __builtin_amdgcn_rsqf(tot * (1.0f / 1024.0f) + EPS);
#pragma unroll
    for (int db = 0; db < 4; ++db)
#pragma unroll
        for (int gp = 0; gp < 2; ++gp) {
            u32x2 a, b;
            a.x = cvt_pk_bf16(o[db][8 * gp + 0] * rstd, o[db][8 * gp + 1] * rstd); a.y = cvt_pk_bf16(o[db][8 * gp + 2] * rstd, o[db][8 * gp + 3] * rstd);
            b.x = cvt_pk_bf16(o[db][8 * gp + 4] * rstd, o[db][8 * gp + 5] * rstd); b.y = cvt_pk_bf16(o[db][8 * gp + 6] * rstd, o[db][8 * gp + 7] * rstd);
            const unsigned sx = hi ? a.x : b.x, sy = hi ? a.y : b.y;
            const unsigned rx = __builtin_amdgcn_ds_bpermute((lane ^ 32) << 2, (int)sx), ry = __builtin_amdgcn_ds_bpermute((lane ^ 32) << 2, (int)sy);
            u32x4 w4;
            if (hi == 0) { w4.x = a.x; w4.y = a.y; w4.z = rx; w4.w = ry; } else { w4.x = rx; w4.y = ry; w4.z = b.x; w4.w = b.y; }
            *(u32x4*)(outp + 32 * db + 16 * gp + 8 * hi) = w4;
        }
}

template <bool NA>
__device__ __forceinline__ void attn_unit(const bf16_t* qp, const bf16_t* kp, const bf16_t* vp, int lo, int nblk, int tq, int r, int qc, const LAS float* rpl, float m, float l,
                                          LAS float* red, int w, int lane, bf16_t* outp) {
    const int hi = lane >> 5;
    bf16x8 qf[8], kf[8], vf[8];
#define ATT_BLK(n_) (NA ? (2 * ((((n_) >> 1) - (lo >> 1)) & 7) + ((n_) & 1)) : (n_))
    const bf16_t* const kp0 = kp; const bf16_t* const vp0 = vp;
    { const int b0 = ATT_BLK(0); kp = kp0 + b0 * 4096; vp = vp0 + b0 * 4096; }
#pragma unroll
    for (int c = 0; c < 8; ++c) qf[c] = *(const bf16x8*)(qp + 16 * c);
#pragma unroll
    for (int c = 0; c < 8; ++c) kf[c] = *(const bf16x8*)(kp + 512 * c);
#pragma unroll
    for (int c = 0; c < 8; ++c) vf[c] = *(const bf16x8*)(vp + 512 * c);
    f32x16 o[4];
#pragma unroll
    for (int db = 0; db < 4; ++db)
#pragma unroll
        for (int i = 0; i < 16; ++i) o[db][i] = 0.f;
    const int cs = min(max(qc - 8, 0), 48);
#pragma unroll 1
    for (int n = 0; n < nblk; ++n) {
        const int bcur = ATT_BLK(n), bnxt = (n + 1 < nblk) ? ATT_BLK(n + 1) : bcur;
        f32x16 s;
#pragma unroll
        for (int i = 0; i < 16; ++i) s[i] = 0.f;
#pragma unroll
        for (int c = 0; c < 8; ++c) s = __builtin_amdgcn_mfma_f32_32x32x16_bf16(kf[c], qf[c], s, 0, 0, 0);
        __builtin_amdgcn_sched_barrier(0);
        kp = kp0 + bnxt * 4096;
#pragma unroll
        for (int c = 0; c < 8; ++c) kf[c] = *(const bf16x8*)(kp + 512 * c);
        __builtin_amdgcn_sched_barrier(0);
        const int kblk = lo + bcur;
        if (NA) {
            const int krow = kblk >> 1, kc0 = 32 * (kblk & 1) + 4 * hi;
            const LAS float* rpr = rpl + (krow - r + 7) * 31 + (kc0 - qc + 15);
            const int vb = kc0 - cs;
            float bias[16];
#pragma unroll
            for (int i = 0; i < 16; ++i) bias[i] = rpr[8 * (i >> 2) + (i & 3)];
#pragma unroll
            for (int i = 0; i < 16; ++i) asm volatile("" : "+v"(bias[i]));
#pragma unroll
            for (int i = 0; i < 16; ++i) {
                const int off = 8 * (i >> 2) + (i & 3);
                s[i] = ((unsigned)(vb + off) < 16u) ? (s[i] + bias[i]) : -INFINITY;
            }
        } else if (kblk - (tq >> 5) == -4 || kblk - (tq >> 5) == 4) {
            const int k0 = kblk * 32 + 4 * hi - tq;
#pragma unroll
            for (int i = 0; i < 16; ++i) { const int dlt = k0 + 8 * (i >> 2) + (i & 3); s[i] = (dlt >= -128 && dlt <= 128) ? s[i] : -INFINITY; }
        }
        float mx = fmaxf(fmaxf(fmaxf(s[0], s[1]), fmaxf(s[2], s[3])), fmaxf(fmaxf(s[4], s[5]), fmaxf(s[6], s[7])));
        mx = fmaxf(mx, fmaxf(fmaxf(fmaxf(s[8], s[9]), fmaxf(s[10], s[11])), fmaxf(fmaxf(s[12], s[13]), fmaxf(s[14], s[15]))));
        mx = fmaxf(mx, shfl_xor_l(mx, 32, lane));
        const float mn = fmaxf(m, mx);
        if (__builtin_amdgcn_ballot_w64(mn > m) != 0ull) {
            const float alpha = __builtin_amdgcn_exp2f(m - mn);
            l *= alpha;
#pragma unroll
            for (int db = 0; db < 4; ++db) o[db] = o[db] * alpha;
            m = mn;
        }
        float sum = 0.f;
#pragma unroll
        for (int i = 0; i < 16; ++i) { s[i] = __builtin_amdgcn_exp2f(s[i] - m); sum += s[i]; }
        l += sum;
        bf16x8 pf[2];
#pragma unroll
        for (int j = 0; j < 2; ++j) {
            u32x4 wv; wv.x = cvt_pk_bf16(s[8 * j + 0], s[8 * j + 1]); wv.y = cvt_pk_bf16(s[8 * j + 2], s[8 * j + 3]); wv.z = cvt_pk_bf16(s[8 * j + 4], s[8 * j + 5]); wv.w = cvt_pk_bf16(s[8 * j + 6], s[8 * j + 7]);
            pf[j] = __builtin_bit_cast(bf16x8, wv);
        }
#pragma unroll
        for (int db = 0; db < 4; ++db)
#pragma unroll
            for (int j = 0; j < 2; ++j) o[db] = __builtin_amdgcn_mfma_f32_32x32x16_bf16(vf[db * 2 + j], pf[j], o[db], 0, 0, 0);
        __builtin_amdgcn_sched_barrier(0);
        vp = vp0 + bnxt * 4096;
#pragma unroll
        for (int c = 0; c < 8; ++c) vf[c] = *(const bf16x8*)(vp + 512 * c);
        __builtin_amdgcn_sched_barrier(0);
    }
    attn_finish(o, l, red, w, lane, outp);
}

#define XB_TMO      128
#define XB_XCNT(j)  (256  + 64 * (j))
#define XB_XSUB(j)  (1280 + 64 * (j))
#define XB_XGEN(j)  (2304 + 64 * (j))
#define XB_TOP      3328
#define XB_TOPGEN   3392
#define XCD_BAR_WORDS 3456
#define XB_SPIN_CAP (1u << 18)

__device__ __forceinline__ unsigned xb_ld(unsigned* p)              { return __hip_atomic_load(p, __ATOMIC_RELAXED, __HIP_MEMORY_SCOPE_AGENT); }
__device__ __forceinline__ unsigned xb_add(unsigned* p, unsigned v) { return __hip_atomic_fetch_add(p, v, __ATOMIC_RELAXED, __HIP_MEMORY_SCOPE_AGENT); }
__device__ __forceinline__ unsigned xb_xcc_id() { return (unsigned)__builtin_amdgcn_s_getreg((3 << 11) | 20) & 0xFu; }
#define XB_SPIN(cond, bar) do { unsigned _sp = 0; while (cond) { __builtin_amdgcn_s_sleep(1); \
    if ((++_sp & 255u) == 0u) { if (xb_ld(&(bar)[XB_TMO])) break; if (_sp > XB_SPIN_CAP) { atomicAdd(&(bar)[XB_TMO], 1u); break; } } } } while (0)

struct XcdBarrier {
    unsigned* bar; unsigned x;
    volatile LAS unsigned* st;
};

__device__ __forceinline__ XcdBarrier xcd_barrier_post(unsigned* bar, volatile LAS unsigned* st) {
    XcdBarrier b; b.bar = bar; b.x = xb_xcc_id(); b.st = st;
    if (threadIdx.x == 0) (void)xb_add(&bar[XB_XCNT(b.x)], 1u);
    return b;
}
__device__ __forceinline__ void xcd_barrier_complete(unsigned* bar, unsigned x, unsigned& nloc, unsigned& nx) {
    const unsigned G = gridDim.x * gridDim.y * gridDim.z;
    unsigned sum, cnt, mine, sp = 0u;
    for (;;) {
        sum = 0u; cnt = 0u; mine = 0u;
#pragma unroll
        for (unsigned j = 0; j < 16; ++j) { const unsigned c = xb_ld(&bar[XB_XCNT(j)]); sum += c; cnt += (c > 0u) ? 1u : 0u; mine = (j == x) ? c : mine; }
        if (sum == G) break;
        __builtin_amdgcn_s_sleep(1);
        if ((++sp & 255u) == 0u) { if (xb_ld(&bar[XB_TMO])) break; if (sp > XB_SPIN_CAP) { atomicAdd(&bar[XB_TMO], 1u); break; } }
    }
    nloc = mine > 0u ? mine : 1u; nx = cnt > 0u ? cnt : 1u;
}

__device__ __forceinline__ void xcd_barrier(const XcdBarrier& b) {
    asm volatile("s_waitcnt vmcnt(0)" ::: "memory");
    __syncthreads();
    if (threadIdx.x == 0) {
        unsigned* bar = b.bar;
        __builtin_amdgcn_s_waitcnt(0);
        unsigned nloc = b.st[0], nx = b.st[1];
        if (nloc == 0u) { xcd_barrier_complete(bar, b.x, nloc, nx); b.st[0] = nloc; b.st[1] = nx; }
        const unsigned old = xb_add(&bar[XB_XSUB(b.x)], 1u);
        const unsigned gen = old / nloc;
        if (old + 1u == (gen + 1u) * nloc) {
            __builtin_amdgcn_fence(__ATOMIC_RELEASE, "agent");
            asm volatile("s_waitcnt vmcnt(0)" ::: "memory");
            const unsigned og = xb_add(&bar[XB_TOP], 1u);
            const unsigned tg = og / nx;
            if (og + 1u == (tg + 1u) * nx) xb_add(&bar[XB_TOPGEN], 1u);
            else XB_SPIN(xb_ld(&bar[XB_TOPGEN]) == tg, bar);
            __builtin_amdgcn_fence(__ATOMIC_ACQUIRE, "agent");
            xb_add(&bar[XB_XGEN(b.x)], 1u);
            asm volatile("s_waitcnt vmcnt(0)" ::: "memory");
        } else {
            XB_SPIN(xb_ld(&bar[XB_XGEN(b.x)]) == gen, bar);
            __builtin_amdgcn_fence(__ATOMIC_ACQUIRE, "agent");
            asm volatile("s_waitcnt vmcnt(0)" ::: "memory");
        }
    }
    __syncthreads();
}


__device__ __forceinline__ void grid_barrier(cg::grid_group& grid, int wave) {
    asm volatile("s_waitcnt vmcnt(0) lgkmcnt(0)" ::: "memory");
    grid.sync();
    if (wave == 0) { __builtin_amdgcn_fence(__ATOMIC_ACQUIRE, "agent"); asm volatile("s_waitcnt vmcnt(0)" ::: "memory"); }
    __syncthreads();
}

struct Args { const float* in[18]; float* out; unsigned char* ws; int use_cg_sync; int pad; };

__global__ void __launch_bounds__(NTHREADS, 2) fwd_kernel(Args a) {
    extern __shared__ __attribute__((aligned(16))) unsigned char lds_raw[];
    LAS unsigned char* lds = (LAS unsigned char*)lds_raw;
    cg::grid_group grid = cg::this_grid();
    if (threadIdx.x < 16) ((LAS unsigned*)(lds + LDS_CTL))[threadIdx.x] = 0u;
    __syncthreads();
    const XcdBarrier xbar = xcd_barrier_post((unsigned*)(a.ws + WS_BAR), (volatile LAS unsigned*)(lds + LDS_CTL));
    const int tid = threadIdx.x, lane0 = tid & 63, wave = __builtin_amdgcn_readfirstlane(tid >> 6);
    const int G = gridDim.x, bid = blockIdx.x;
    const int gw = bid * NWAVES + wave, NGW = G * NWAVES;
    const int NGT = G * NTHREADS;

    const float* x_in = a.in[0]; const int* positions = (const int*)a.in[1];
    const float* ln1_g = a.in[2]; const float* w_in = a.in[3]; const float* qn_a = a.in[4]; const float* kn_a = a.in[5];
    const float* rpb = a.in[6]; const float* qn_b = a.in[7]; const float* kn_b = a.in[8]; const float* sink = a.in[9];
    const float* on_a = a.in[10]; const float* on_b = a.in[11]; const float* w_out = a.in[12]; const float* ln2_g = a.in[13];
    const float* w_up = a.in[14]; const float* conv_w = a.in[15]; const float* conv_b = a.in[16]; const float* w_down = a.in[17];
    float* xout = a.out;
    unsigned char* ws = a.ws;
    float* ssq1 = (float*)(ws + WS_SSQ); float* ssq2 = (float*)(ws + WS_SSQ2);
    bf16_t* WinT = (bf16_t*)(ws + WS_WIN); bf16_t* WoutT = (bf16_t*)(ws + WS_WOUT); bf16_t* WupT = (bf16_t*)(ws + WS_WUP); bf16_t* WdnT = (bf16_t*)(ws + WS_WDN);
    bf16_t* xb = (bf16_t*)(ws + WS_XB); bf16_t* proj = (bf16_t*)(ws + WS_PROJ); bf16_t* V2 = (bf16_t*)(ws + WS_VT); bf16_t* K2 = (bf16_t*)(ws + WS_K2); bf16_t* on = (bf16_t*)(ws + WS_ON);
    float* Ub = (float*)(ws + WS_U); bf16_t* act = (bf16_t*)(ws + WS_ACT);

    {
        LAS unsigned* scr = (LAS unsigned*)(lds + wave * 18432);
        constexpr int I_IN = (D / 64) * (PW / 128);
        for (int it = gw; it < I_IN; it += NGW) transpose_item(w_in, D, PW, ln1_g, ln1_g + 1024, WinT, scr, it, lane0, false, true);
        for (int i = bid * NTHREADS + tid; i < 192 * (D / 8); i += G * NTHREADS) { const int gr = i / (D / 8), c8 = i - gr * (D / 8); const long rowi = (gr == 0) ? -1 : (S + gr - 1);
            *(u32x4*)(xb + rowi * (long)D + c8 * 8) = (u32x4){0u, 0u, 0u, 0u}; }
        for (int row = gw; row < S; row += NGW) {
            const f32x4* xr = (const f32x4*)(x_in + (size_t)row * D) + lane0;
            u32x2* o8 = (u32x2*)(xb + (size_t)row * D) + lane0;
            float s = 0.f;
#pragma unroll
            for (int j = 0; j < 8; ++j) { const f32x4 v = xr[64 * j]; s += (v[0] * v[0] + v[1] * v[1]) + (v[2] * v[2] + v[3] * v[3]); u32x2 w; w.x = cvt_pk_bf16(v[0], v[1]); w.y = cvt_pk_bf16(v[2], v[3]); o8[64 * j] = w; }
            s = wave_sum(s, lane0);
            if (lane0 < 32) ssq1[(size_t)row * 32 + lane0] = (lane0 == 0) ? s : 0.f;
        }
    }
    if (a.use_cg_sync) grid_barrier(grid, wave); else xcd_barrier(xbar);

    int ltid = threadIdx.x;
#pragma unroll 1
    for (int ph = 0; ph < DEPTH * 5; ++ph) {
        const int layer = ph / 5, k = ph - 5 * layer;
        asm volatile("" : "+v"(ltid));
        if (k != 1) {
            pg8::Gemm g; pg8::Epi E;
            const bool m1 = (k == 2) || (k == 4);
            g.M = S; g.arow_step = (k == 3) ? 254 : 256; g.arow_off = (k == 3) ? -1 : 0;
            g.A = (k == 2) ? on : ((k == 4) ? act : xb);
            g.Bt = (k == 0) ? WinT + (size_t)layer * PW * D : (k == 2) ? WoutT + (size_t)layer * D * D : (k == 3) ? WupT + (size_t)layer * UW * D : WdnT + (size_t)layer * D * DFF;
            g.N = (k == 0) ? PW : (k == 3) ? UW : D;
            g.K = (k == 4) ? DFF : D;
            E.mode = m1 ? ((k == 4 && layer + 1 == DEPTH) ? 3 : 1) : ((k == 3) ? 2 : 0);
            E.O = (k == 0) ? proj : act; E.ldc = (k == 0) ? PW : DFF;
            E.cw = conv_w + (size_t)layer * 3 * UW; E.cbv = conv_b + (size_t)layer * UW; E.Ub = Ub;
            E.ssq = (k == 0) ? ssq1 : ssq2;
            E.xin = (k == 2 && layer == 0) ? x_in : xout; E.xout = xout; E.xb = xb;
            E.ssq_next = (k == 2) ? ssq2 : ssq1;
            E.K2 = K2; E.V2 = V2; E.positions = positions; E.nqa = qn_a + layer * 128; E.nka = kn_a + layer * 128; E.nqb = qn_b + layer * 128; E.nkb = kn_b + layer * 128;
            pg8::StaticOrder so; so.init((k == 3) ? 33 * 256 : S, g.N, G, bid);
            pg8::gemm_phase(lds, g, so, E, ltid);
            asm volatile("" : "+v"(ltid)); const int lane = ltid & 63;
            constexpr int I_IN = (D / 64) * (PW / 128), I_OUT = (D / 64) * (D / 128), I_UP = (D / 64) * (UW / 128), I_DN = (DFF / 64) * (D / 128);
            const int first = (G == 256) ? ((k == 0) ? 64 : 172) : 0;
            if ((k == 0 || k == 3) && bid >= first) {
                LAS unsigned* scr = (LAS unsigned*)(lds + wave * 18432);
                const int n_in = (layer + 1 < DEPTH) ? I_IN : 0;
                const int nit = (k == 0) ? (I_OUT + I_UP + n_in) : I_DN, nw = (G - first) * NWAVES;
                for (int it = (bid - first) * NWAVES + wave; it < nit; it += nw) {
                    const float* W; const float* g0; const float* g1; bf16_t* WT; int K_, N_, r = it;
                    if (k == 3) { W = w_down + (size_t)layer * DFF * D; K_ = DFF; N_ = D; g0 = nullptr; g1 = nullptr; WT = WdnT + (size_t)layer * D * DFF; }
                    else if (r < I_OUT) { W = w_out + (size_t)layer * D * D; K_ = D; N_ = D; g0 = on_a + layer * 1024; g1 = on_b + layer * 1024; WT = WoutT + (size_t)layer * D * D; }
                    else if (r < I_OUT + I_UP) { r -= I_OUT; W = w_up + (size_t)layer * D * UW; K_ = D; N_ = UW; g0 = ln2_g + layer * D; g1 = g0 + 1024; WT = WupT + (size_t)layer * UW * D; }
                    else { r -= I_OUT + I_UP; const int l = layer + 1; W = w_in + (size_t)l * D * PW; K_ = D; N_ = PW; g0 = ln1_g + l * D; g1 = g0 + 1024; WT = WinT + (size_t)l * PW * D; }
                    transpose_item(W, K_, N_, g0, g1, WT, scr, r, lane, N_ == UW, N_ == PW);
                }
            }
        }
        else if (k == 1) {
            const int lane = ltid & 63;
            LAS float* redbase = (LAS float*)lds;
            LAS float* rpl = (LAS float*)(lds + 4096 + wave * 4096 + 256);
            const int ql = lane & 31, hi = lane >> 5, w = wave;
            {
                const float* rp = rpb + ((size_t)layer * 8 + w) * (15 * 31);
                for (int i = lane; i < 15 * 31; i += 64) rpl[i] = rp[i] * LOG2E;
                asm volatile("s_waitcnt lgkmcnt(0)" ::: "memory");
            }
            int ucount = 0;
#pragma unroll 1
            for (int u0 = bid; u0 < 512; u0 += G, ++ucount) {
                const int u = (G == 256) ? ((u0 & ~255) + (u0 & 7) * 32 + ((u0 & 255) >> 3)) : u0;
                LAS float* red = redbase + (ucount & 1) * 256;
                if (u < 256) {
                    const int r = u >> 1, h = u & 1;
                    const int qc = 32 * h + ql, tq = r * 64 + qc;
                    const int lo = 2 * min(max(r - 4, 0), 120);
                    const size_t fo = ((size_t)(w * 256 + lo) * 8) * 512 + lane * 8;
                    attn_unit<true>(proj + (size_t)tq * PW + w * 128 + 8 * hi, K2 + fo, V2 + fo, lo, 16, tq, r, qc, rpl, -1e30f, 0.f, red, w, lane, on + (size_t)tq * D + w * 128);
                } else {
                    const int qb = u - 256, tq = qb * 32 + ql, kvh = w >> 2;
                    const int lo = max(qb - 4, 0), hb = min(qb + 4, 255);
                    const size_t fo = ((size_t)((8 + kvh) * 256 + lo) * 8) * 512 + lane * 8;
                    attn_unit<false>(proj + (size_t)tq * PW + 3072 + w * 128 + 8 * hi, K2 + fo, V2 + fo, lo, hb - lo + 1, tq, 0, 0, rpl, sink[layer * 8 + w] * LOG2E, (hi == 0) ? 1.0f : 0.0f, red, w, lane,
                                     on + (size_t)tq * D + 1024 + w * 128);
                }
            }
        }
        if (ph + 1 < DEPTH * 5) xcd_barrier(xbar);
    }
}

extern "C" void kernel_launch(void* const* d_in, const int* in_sizes, int n_in, void* d_out, int out_size, void* d_ws, size_t ws_size, hipStream_t stream) {
    static int grid = 0;
    if (grid == 0) {
        if (n_in != 18 || out_size != S * D || ws_size < WS_END) { fprintf(stderr, "kernel_launch: unexpected shapes (n_in %d out %d ws %zu)\n", n_in, out_size, ws_size); grid = -1; return; }
        int dev = 0, cus = 0, per_cu = 0;
        hipGetDevice(&dev);
        hipDeviceGetAttribute(&cus, hipDeviceAttributeMultiprocessorCount, dev);
        if (hipFuncSetAttribute((const void*)fwd_kernel, hipFuncAttributeMaxDynamicSharedMemorySize, LDS_BYTES) != hipSuccess) { fprintf(stderr, "kernel_launch: hipFuncSetAttribute failed\n"); grid = -1; return; }
        if (hipOccupancyMaxActiveBlocksPerMultiprocessor(&per_cu, (const void*)fwd_kernel, NTHREADS, LDS_BYTES) != hipSuccess || per_cu < 1) { fprintf(stderr, "kernel_launch: occupancy query failed (%d)\n", per_cu); per_cu = 1; }
        (void)hipGetLastError();
        grid = cus * 1;
        if (grid > 256) grid = 256;
    }
    if (grid < 0) return;
    if (hipMemsetAsync((char*)d_ws + WS_BAR, 0, 16384, stream) != hipSuccess) { fprintf(stderr, "kernel_launch: hipMemsetAsync failed\n"); return; }
    Args a{};
    for (int i = 0; i < 18; ++i) a.in[i] = (const float*)d_in[i];
    a.out = (float*)d_out; a.ws = (unsigned char*)d_ws;
    void* args[] = {&a};
    hipError_t e = hipLaunchCooperativeKernel((const void*)fwd_kernel, dim3(grid), dim3(NTHREADS), args, LDS_BYTES, stream);
    if (e != hipSuccess) fprintf(stderr, "cooperative launch failed: %s (grid %d)\n", hipGetErrorString(e), grid);
}
```
